# Optimizing an MI355X kernel written in HIP

```python
import jax, jax.numpy as jnp
from jax import lax
import numpy as np

D_MODEL = 2048
BATCH = 16
SEQ = 2048
DEPTH = 2

HEAD_DIM = 128
N_Q_GLOBAL = 8
N_KV_GLOBAL = 2
N_Q_LOCAL = 8
N_KV_LOCAL = 2
QA = N_Q_GLOBAL * HEAD_DIM
KA = N_KV_GLOBAL * HEAD_DIM
QB = N_Q_LOCAL * HEAD_DIM
KB = N_KV_LOCAL * HEAD_DIM
MIX_WIDTH = QA + QB
IN_COLS = QA + 2 * KA + QB + 2 * KB
WINDOW = 128
BLOCK_Q = 128
GRID_W = 64
ROPE_THETA = 10000.0
FFN_DIM = 5632
N_EXPERTS = 8
TOP_K = 2
EPS = 1e-6
N_DENSE = (DEPTH + 1) // 2
N_MOE = DEPTH // 2

kernel_name = "hybrid_parallel_group_encoder"


def rms_norm(x, g):
    xf = x.astype(jnp.float32)
    y = xf * lax.rsqrt(jnp.mean(xf * xf, axis=-1, keepdims=True) + EPS)
    return (y * g.astype(jnp.float32)).astype(x.dtype)


def rope_angles(pos, dim):
    inv = 1.0 / (ROPE_THETA ** (jnp.arange(0, dim, 2, dtype=jnp.float32) / dim))
    return pos.astype(jnp.float32)[:, None] * inv[None, :]


def apply_rope(x, ang):
    half = x.shape[-1] // 2
    cos = jnp.cos(ang)[None, :, None, :]
    sin = jnp.sin(ang)[None, :, None, :]
    x1 = x[..., :half].astype(jnp.float32)
    x2 = x[..., half:].astype(jnp.float32)
    return jnp.concatenate([x1 * cos - x2 * sin, x2 * cos + x1 * sin], axis=-1).astype(x.dtype)


def apply_axial_rope(x, ang_row, ang_col):
    half = x.shape[-1] // 2
    return jnp.concatenate([apply_rope(x[..., :half], ang_row),
                            apply_rope(x[..., half:], ang_col)], axis=-1)


def global_attention(q, k, v):
    B, S, Hq, Dh = q.shape
    Hkv = k.shape[2]
    G = Hq // Hkv
    nb = S // BLOCK_Q
    qb = q.reshape(B, nb, BLOCK_Q, Hkv, G, Dh).transpose(1, 0, 2, 3, 4, 5)
    scale = Dh ** -0.5

    def one_block(q_blk):
        s = jnp.einsum('bqkgd,bskd->bkgqs', q_blk, k,
                       preferred_element_type=jnp.float32) * scale
        p = jax.nn.softmax(s, axis=-1).astype(v.dtype)
        return jnp.einsum('bkgqs,bskd->bqkgd', p, v)

    o = lax.map(one_block, qb)
    return o.transpose(1, 0, 2, 3, 4, 5).reshape(B, S, Hq * Dh)


def window_attention(q, k, v, sinks):
    B, S, Hq, Dh = q.shape
    Hkv = k.shape[2]
    G = Hq // Hkv
    nb = S // BLOCK_Q
    pad = ((0, 0), (BLOCK_Q, BLOCK_Q), (0, 0), (0, 0))
    kp = jnp.pad(k, pad).reshape(B, nb + 2, BLOCK_Q, Hkv, Dh)
    vp = jnp.pad(v, pad).reshape(B, nb + 2, BLOCK_Q, Hkv, Dh)
    kw = jnp.concatenate([kp[:, :-2], kp[:, 1:-1], kp[:, 2:]], axis=2)
    vw = jnp.concatenate([vp[:, :-2], vp[:, 1:-1], vp[:, 2:]], axis=2)
    qb = q.reshape(B, nb, BLOCK_Q, Hkv, G, Dh)

    q_pos = jnp.arange(S).reshape(nb, BLOCK_Q)
    k_pos = jnp.arange(nb)[:, None] * BLOCK_Q - BLOCK_Q + jnp.arange(3 * BLOCK_Q)[None, :]
    diff = k_pos[:, None, :] - q_pos[:, :, None]
    mask = (jnp.abs(diff) <= WINDOW) & (k_pos[:, None, :] >= 0) & (k_pos[:, None, :] < S)

    scale = Dh ** -0.5
    s = jnp.einsum('bnqkgd,bnskd->bnkgqs', qb, kw,
                   preferred_element_type=jnp.float32) * scale
    s = jnp.where(mask[None, :, None, None], s, -jnp.inf)
    sink = sinks.astype(jnp.float32).reshape(1, 1, Hkv, G, 1, 1)
    m = jnp.maximum(jnp.max(s, axis=-1, keepdims=True), sink)
    e = jnp.exp(s - m)
    p = (e / (jnp.sum(e, axis=-1, keepdims=True) + jnp.exp(sink - m))).astype(v.dtype)
    o = jnp.einsum('bnkgqs,bnskd->bnqkgd', p, vw)
    return o.reshape(B, S, Hq * Dh)


def hybrid_mixer(h, w_in, q_norm_g, k_norm_g, sinks, grp_norm_a, grp_norm_b, w_out,
                 ang_row, ang_col, ang_seq):
    B, S, _ = h.shape
    proj = h @ w_in
    cuts = [QA, QA + KA, QA + 2 * KA, QA + 2 * KA + QB, QA + 2 * KA + QB + KB]
    qa, ka, va, qb, kb, vb = jnp.split(proj, cuts, axis=-1)

    qa = rms_norm(qa.reshape(B, S, N_Q_GLOBAL, HEAD_DIM), q_norm_g)
    ka = rms_norm(ka.reshape(B, S, N_KV_GLOBAL, HEAD_DIM), k_norm_g)
    va = va.reshape(B, S, N_KV_GLOBAL, HEAD_DIM)
    qa = apply_axial_rope(qa, ang_row, ang_col)
    ka = apply_axial_rope(ka, ang_row, ang_col)
    out_a = global_attention(qa, ka, va)

    qb = apply_rope(qb.reshape(B, S, N_Q_LOCAL, HEAD_DIM), ang_seq)
    kb = apply_rope(kb.reshape(B, S, N_KV_LOCAL, HEAD_DIM), ang_seq)
    vb = vb.reshape(B, S, N_KV_LOCAL, HEAD_DIM)
    out_b = window_attention(qb, kb, vb, sinks)

    merged = jnp.concatenate([rms_norm(out_a, grp_norm_a), rms_norm(out_b, grp_norm_b)], axis=-1)
    return merged @ w_out


def swiglu(t, w_gate, w_up, w_down):
    return (jax.nn.silu(t @ w_gate) * (t @ w_up)) @ w_down


def moe_swiglu(h, w_router, w_gate, w_up, w_down):
    B, S, D = h.shape
    t = h.reshape(B * S, D)
    logits = (t @ w_router).astype(jnp.float32)
    top_v, top_i = lax.top_k(logits, TOP_K)
    wts = jax.nn.softmax(top_v, axis=-1)
    combine = jnp.sum(jax.nn.one_hot(top_i, N_EXPERTS, dtype=jnp.float32) * wts[..., None], axis=1)
    out = jnp.zeros_like(t)
    for e in range(N_EXPERTS):
        out = out + combine[:, e:e + 1].astype(t.dtype) * swiglu(t, w_gate[e], w_up[e], w_down[e])
    return out.reshape(B, S, D)


def setup_inputs(seed: int = 0) -> dict:
    key = jax.random.key(seed)
    ks = jax.random.split(key, 22)
    D, F, E, L = D_MODEL, FFN_DIM, N_EXPERTS, DEPTH
    nrm = jax.random.normal
    gain = lambda k, shape: 1.0 + 0.1 * nrm(k, shape, jnp.float32)
    return {
        "x": nrm(ks[0], (BATCH, SEQ, D), jnp.float32),
        "c": nrm(ks[1], (BATCH, D), jnp.float32),
        "w_mod": nrm(ks[2], (L, D, 6 * D), jnp.float32) * D ** -0.5,
        "b_mod": 0.01 * nrm(ks[3], (L, 6 * D), jnp.float32),
        "pre_mix_g": gain(ks[4], (L, D)),
        "post_mix_g": gain(ks[5], (L, D)),
        "pre_ffn_g": gain(ks[6], (L, D)),
        "post_ffn_g": gain(ks[7], (L, D)),
        "w_in": nrm(ks[8], (L, D, IN_COLS), jnp.float32) * D ** -0.5,
        "q_norm_g": gain(ks[9], (L, HEAD_DIM)),
        "k_norm_g": gain(ks[10], (L, HEAD_DIM)),
        "sinks": nrm(ks[11], (L, N_Q_LOCAL), jnp.float32),
        "grp_norm_a": gain(ks[12], (L, QA)),
        "grp_norm_b": gain(ks[13], (L, QB)),
        "w_out": nrm(ks[14], (L, MIX_WIDTH, D), jnp.float32) * MIX_WIDTH ** -0.5,
        "w_ffn_gate": nrm(ks[15], (N_DENSE, D, F), jnp.float32) * D ** -0.5,
        "w_ffn_up": nrm(ks[16], (N_DENSE, D, F), jnp.float32) * D ** -0.5,
        "w_ffn_down": nrm(ks[17], (N_DENSE, F, D), jnp.float32) * F ** -0.5,
        "w_router": nrm(ks[18], (N_MOE, D, E), jnp.float32) * D ** -0.5,
        "w_exp_gate": nrm(ks[19], (N_MOE, E, D, F), jnp.float32) * D ** -0.5,
        "w_exp_up": nrm(ks[20], (N_MOE, E, D, F), jnp.float32) * D ** -0.5,
        "w_exp_down": nrm(ks[21], (N_MOE, E, F, D), jnp.float32) * F ** -0.5,
    }


def reference(x, c, w_mod, b_mod, pre_mix_g, post_mix_g, pre_ffn_g, post_ffn_g,
              w_in, q_norm_g, k_norm_g, sinks, grp_norm_a, grp_norm_b, w_out,
              w_ffn_gate, w_ffn_up, w_ffn_down,
              w_router, w_exp_gate, w_exp_up, w_exp_down):
    S = x.shape[1]
    rows = S // GRID_W
    row_idx = jnp.repeat(jnp.arange(rows), GRID_W, total_repeat_length=S)
    col_idx = jnp.tile(jnp.arange(GRID_W), rows)
    ang_row = rope_angles(row_idx, HEAD_DIM // 2)
    ang_col = rope_angles(col_idx, HEAD_DIM // 2)
    ang_seq = rope_angles(jnp.arange(S), HEAD_DIM)
    c_act = jax.nn.silu(c)

    for l in range(DEPTH):
        mod = c_act @ w_mod[l] + b_mod[l]
        sh1, sc1, g1, sh2, sc2, g2 = jnp.split(mod, 6, axis=-1)

        h = rms_norm(x, pre_mix_g[l]) * (1.0 + sc1[:, None]) + sh1[:, None]
        y = hybrid_mixer(h, w_in[l], q_norm_g[l], k_norm_g[l], sinks[l],
                         grp_norm_a[l], grp_norm_b[l], w_out[l], ang_row, ang_col, ang_seq)
        x = x + g1[:, None] * rms_norm(y, post_mix_g[l])

        h = rms_norm(x, pre_ffn_g[l]) * (1.0 + sc2[:, None]) + sh2[:, None]
        if l % 2 == 0:
            i = l // 2
            y = swiglu(h, w_ffn_gate[i], w_ffn_up[i], w_ffn_down[i])
        else:
            i = l // 2
            y = moe_swiglu(h, w_router[i], w_exp_gate[i], w_exp_up[i], w_exp_down[i])
        x = x + g2[:, None] * rms_norm(y, post_ffn_g[l])
    return x
```

```cpp
#include <hip/hip_runtime.h>
#include <cstdio>
#include <cstdint>

#define GAS __attribute__((address_space(1)))
#define LAS __attribute__((address_space(3)))
typedef unsigned short bf16;
typedef unsigned v4u __attribute__((ext_vector_type(4)));
typedef unsigned v2u __attribute__((ext_vector_type(2)));
typedef float f32x4 __attribute__((ext_vector_type(4)));
typedef float f32x2 __attribute__((ext_vector_type(2)));
typedef float f32x16 __attribute__((ext_vector_type(16)));
typedef short bf16x8 __attribute__((ext_vector_type(8)));

#ifndef PROBE_DUP
#define PROBE_DUP 0
#endif
constexpr int BATCH = 16, SEQ = 2048, DM = 2048, T = BATCH * SEQ, NQKV = 3072, FF = 5632, NE = 8, HD = 128, DEPTH = 2, NMOD = 6 * DM;
constexpr int QA_OFF = 0, KA_OFF = 1024, VA_OFF = 1280, QB_OFF = 1536, KB_OFF = 2560, VB_OFF = 2816;
constexpr float EPS = 1e-6f;
constexpr int NSLOT = 2 * T + NE * 256;
constexpr int NWAVES = 8, NTHR = NWAVES * 64;

constexpr size_t MiB = 1u << 20;
constexpr size_t WS_CTL = 0, CTL_ZERO_BYTES = 1 * MiB;
constexpr size_t WS_MODV = 1 * MiB;
constexpr size_t WS_ROPE = 3 * MiB;
constexpr size_t WS_TOPI = 5 * MiB;
constexpr size_t WS_TOPW = WS_TOPI + 256 * 1024;
constexpr size_t WS_SLOT = WS_TOPW + 256 * 1024;
constexpr size_t WS_ROWL = 6 * MiB;
constexpr size_t WS_CNT  = 6 * MiB + 512 * 1024;
constexpr size_t WS_TILE = WS_CNT + 16 * 1024;
constexpr size_t WS_GCAT = 7 * MiB;
constexpr size_t WS_WEXP = 8 * MiB;
constexpr size_t WS_H    = 536 * MiB;
constexpr size_t WS_D    = 664 * MiB;
constexpr size_t WS_QKV  = WS_D, WS_ATT = WS_D + 192 * MiB, WS_Y = WS_D + 320 * MiB;
constexpr size_t WS_ACT  = WS_D, WS_Y2 = WS_D + 352 * MiB;
constexpr size_t WS_ACTM = WS_D, WS_YS = WS_D + 726 * MiB;
constexpr size_t WS_END  = WS_D + 990 * MiB;
constexpr size_t WS_EGU = WS_WEXP, EGU_STRIDE = 22 * MiB, WS_EDN = WS_WEXP + 176 * MiB, EDN_STRIDE = 11 * MiB;
constexpr size_t WS_H8 = WS_WEXP + 264 * MiB;
constexpr size_t WS_SSQ = 336 * MiB, WS_FAC = 338 * MiB;
constexpr size_t WS_XB = 340 * MiB;
constexpr size_t WS_LW = WS_D + 884 * MiB, WS_WIN = WS_LW, WIN_STRIDE = 12 * MiB, WS_WOUT = WS_LW + 24 * MiB, WOUT_STRIDE = 8 * MiB, WS_WGU = WS_LW + 40 * MiB, WS_WDN = WS_LW + 84 * MiB;
static_assert(WS_H8 + 64 * MiB <= WS_XB && WS_XB + 128 * MiB <= WS_H, "residual buffer");
static_assert(WS_EDN + 8 * EDN_STRIDE <= WS_H8 && WS_H8 + 64 * MiB <= WS_H && WS_WDN + 22 * MiB <= WS_END && WS_LW >= WS_YS, "weight copies");
constexpr float W8_SCALE = 256.0f, W8_INV = 1.0f / 256.0f;
static_assert((size_t)NSLOT * FF * 2 <= 726 * MiB && (size_t)NSLOT * DM * 2 <= 264 * MiB, "moe scratch");

constexpr int LDS_BYTES = 147456;

template <int CTRL, int RM> __device__ __forceinline__ float dpp_add(float v) { return v + __builtin_bit_cast(float, __builtin_amdgcn_update_dpp(0, __builtin_bit_cast(int, v), CTRL, RM, 0xf, false)); }
__device__ __forceinline__ float wave_sum(float v) {
    v = dpp_add<0xB1, 0xf>(v); v = dpp_add<0x4E, 0xf>(v); v = dpp_add<0x141, 0xf>(v); v = dpp_add<0x140, 0xf>(v);
    v = dpp_add<0x142, 0xa>(v); v = dpp_add<0x143, 0xc>(v);
    return __builtin_bit_cast(float, __builtin_amdgcn_readlane(__builtin_bit_cast(int, v), 63));
}
__device__ __forceinline__ unsigned f2bf(float f) { unsigned u = __builtin_bit_cast(unsigned, f); return (u + 0x7fffu + ((u >> 16) & 1u)) >> 16; }
__device__ __forceinline__ unsigned pk2(float lo, float hi) { return f2bf(lo) | (f2bf(hi) << 16); }
__device__ __forceinline__ float bflo(unsigned w) { return __builtin_bit_cast(float, w << 16); }
__device__ __forceinline__ float bfhi(unsigned w) { return __builtin_bit_cast(float, w & 0xffff0000u); }

__device__ __forceinline__ int fresh_tid() { int t = threadIdx.x; asm volatile("" : "+v"(t)); return t; }
struct Args { const float* in[22]; float* out; unsigned char* ws; int ph_lo, ph_hi, layer, pad; };

__device__ __forceinline__ void ph_mod(const Args& a, LAS unsigned char* lds, int bid, int nb, int tid) {
    LAS float* cT = (LAS float*)lds;
    LAS float* red = (LAS float*)lds;
    const float* c = a.in[1];
    float* modv = (float*)(a.ws + WS_MODV);
    const int wave = tid >> 6, lane = tid & 63, cl = lane & 31, kp = lane >> 5;
    for (int u = bid; u < 768; u += nb) {
        for (int i = tid; i < 16 * 2048; i += NTHR) { const int b = i >> 11, k = i & 2047; const float v = c[i]; cT[k * 16 + b] = v / (1.f + __expf(-v)); }
        __syncthreads();
        const int l = u / 384, n0 = (u % 384) * 32;
        const float* W = a.in[2] + (size_t)l * DM * NMOD + n0 + cl;
        float acc[16];
#pragma unroll
        for (int b = 0; b < 16; ++b) acc[b] = 0.f;
        const int k0 = wave * 256 + kp;
        for (int i0 = 0; i0 < 128; i0 += 16) {
            float wv[16];
#pragma unroll
            for (int i = 0; i < 16; ++i) wv[i] = __builtin_nontemporal_load(W + (size_t)(k0 + 2 * (i0 + i)) * NMOD);
            asm volatile("" ::: "memory");
#pragma unroll
            for (int i = 0; i < 16; ++i) { const int k = k0 + 2 * (i0 + i);
                const f32x4 c0 = *(const LAS f32x4*)(cT + k * 16), c1 = *(const LAS f32x4*)(cT + k * 16 + 4), c2 = *(const LAS f32x4*)(cT + k * 16 + 8), c3 = *(const LAS f32x4*)(cT + k * 16 + 12);
                const float w = wv[i];
                acc[0] += c0.x * w; acc[1] += c0.y * w; acc[2] += c0.z * w; acc[3] += c0.w * w;
                acc[4] += c1.x * w; acc[5] += c1.y * w; acc[6] += c1.z * w; acc[7] += c1.w * w;
                acc[8] += c2.x * w; acc[9] += c2.y * w; acc[10] += c2.z * w; acc[11] += c2.w * w;
                acc[12] += c3.x * w; acc[13] += c3.y * w; acc[14] += c3.z * w; acc[15] += c3.w * w; }
        }
        __syncthreads();
#pragma unroll
        for (int b = 0; b < 16; ++b) red[((wave * 2 + kp) * 16 + b) * 32 + cl] = acc[b];
        __syncthreads();
        { const int b = tid >> 5, n = tid & 31; float s = 0.f;
#pragma unroll
            for (int p = 0; p < 16; ++p) s += red[(p * 16 + b) * 32 + n];
            const int col = n0 + n, j = col >> 11, d = col & 2047;
            s += a.in[3][l * NMOD + col];
            float o = s;
            if (j == 1) o = a.in[4][l * DM + d] * (1.f + s);
            else if (j == 2) o = s * a.in[5][l * DM + d];
            else if (j == 4) o = a.in[6][l * DM + d] * (1.f + s);
            else if (j == 5) o = s * a.in[7][l * DM + d];
            modv[(size_t)(l * 16 + b) * NMOD + col] = o; }
        __syncthreads();
    }
}
__device__ __forceinline__ void ph_tables(const Args& a, int bid, int nb, int tid) {
    float* cosA = (float*)(a.ws + WS_ROPE); float* sinA = cosA + 2048 * 64; float* cosB = sinA + 2048 * 64; float* sinB = cosB + 2048 * 64;
    for (int i = bid * NTHR + tid; i < 2048 * 64; i += nb * NTHR) {
        const int pos = i >> 6, j = i & 63;
        {
            const int p = (j < 32) ? (pos >> 6) : (pos & 63), fj = j & 31;
            const float inv = 1.0f / powf(10000.0f, (float)(2 * fj) / 64.0f);
            const float ang = (float)p * inv;
            const double rev = (double)ang * 0.15915494309189535; const float fr = (float)(rev - rint(rev));
            cosA[i] = __builtin_amdgcn_cosf(fr); sinA[i] = __builtin_amdgcn_sinf(fr);
        }
        {
            const float inv = 1.0f / powf(10000.0f, (float)(2 * j) / 128.0f);
            const float ang = (float)pos * inv;
            const double rev = (double)ang * 0.15915494309189535; const float fr = (float)(rev - rint(rev));
            cosB[i] = __builtin_amdgcn_cosf(fr); sinB[i] = __builtin_amdgcn_sinf(fr);
        }
    }
    float* gcat = (float*)(a.ws + WS_GCAT);
    for (int i = bid * NTHR + tid; i < DEPTH * 2048; i += nb * NTHR) {
        const int l = i >> 11, k = i & 2047;
        gcat[i] = (k < 1024) ? a.in[12][l * 1024 + k] : a.in[13][l * 1024 + (k - 1024)];
    }
}

template <int YMODE, int HAS_H> struct RowIn { f32x4 x[8]; v2u y0[YMODE >= 1 ? 8 : 1]; v2u y1[YMODE == 2 ? 8 : 1]; f32x4 g[YMODE >= 1 ? 8 : 1]; f32x4 a[HAS_H ? 8 : 1]; f32x4 s[HAS_H ? 8 : 1]; float w0, w1; };
template <int YMODE, int HAS_H, bool XB  >
__device__ __forceinline__ void row_load(RowIn<YMODE, HAS_H>& R, int t, int lane, const float* __restrict__ xin, const bf16* __restrict__ ysrc, const int* __restrict__ slot_of, const float* __restrict__ topw,
                                         const float* __restrict__ Gv, const float* __restrict__ Av, const float* __restrict__ Sv) {
    v2u xb[8];
    if constexpr (XB) { const v2u* xp = (const v2u*)((const bf16*)xin + (size_t)t * DM) + lane;
#pragma unroll
        for (int j = 0; j < 8; ++j) xb[j] = xp[64 * j];
    } else { const f32x4* xp = (const f32x4*)(xin + (size_t)t * DM) + lane;
#pragma unroll
        for (int j = 0; j < 8; ++j) R.x[j] = __builtin_nontemporal_load(xp + 64 * j); }
    if constexpr (YMODE == 1) {
        const v2u* yp = (const v2u*)(ysrc + (size_t)t * DM) + lane;
#pragma unroll
        for (int j = 0; j < 8; ++j) R.y0[j] = yp[64 * j];
    } else if constexpr (YMODE == 2) {
        const int s0 = slot_of[2 * t], s1 = slot_of[2 * t + 1]; R.w0 = topw[2 * t]; R.w1 = topw[2 * t + 1];
        const v2u* y0 = (const v2u*)(ysrc + (size_t)s0 * DM) + lane; const v2u* y1 = (const v2u*)(ysrc + (size_t)s1 * DM) + lane;
#pragma unroll
        for (int j = 0; j < 8; ++j) { R.y0[j] = y0[64 * j]; R.y1[j] = y1[64 * j]; }
    }
    if constexpr (YMODE != 0) { const f32x4* gp = (const f32x4*)Gv + lane;
#pragma unroll
        for (int j = 0; j < 8; ++j) R.g[j] = gp[64 * j]; }
    if constexpr (HAS_H != 0) { const f32x4* ap = (const f32x4*)Av + lane; const f32x4* sp = (const f32x4*)Sv + lane;
#pragma unroll
        for (int j = 0; j < 8; ++j) { R.a[j] = ap[64 * j]; R.s[j] = sp[64 * j]; } }
    asm volatile("" ::: "memory");
    if constexpr (XB) {
#pragma unroll
        for (int j = 0; j < 8; ++j) R.x[j] = (f32x4){bflo(xb[j].x), bfhi(xb[j].x), bflo(xb[j].y), bfhi(xb[j].y)}; }
}
struct Slots { int s0, s1; float w0, w1; };
__device__ __forceinline__ void row_load_moe(RowIn<2, 0>& R, int t, int tn, int lane, const bf16* __restrict__ xin, const bf16* __restrict__ ysrc, const int* __restrict__ slot_of, const float* __restrict__ topw,
                                             const Slots& cur, Slots& nxt, const float* __restrict__ Gv) {
    v2u xb[8];
    const v2u* xp = (const v2u*)(xin + (size_t)t * DM) + lane;
#pragma unroll
    for (int j = 0; j < 8; ++j) xb[j] = xp[64 * j];
    R.w0 = cur.w0; R.w1 = cur.w1;
    const v2u* y0 = (const v2u*)(ysrc + (size_t)cur.s0 * DM) + lane; const v2u* y1 = (const v2u*)(ysrc + (size_t)cur.s1 * DM) + lane;
#pragma unroll
    for (int j = 0; j < 8; ++j) { R.y0[j] = y0[64 * j]; R.y1[j] = y1[64 * j]; }
    const f32x4* gp = (const f32x4*)Gv + lane;
#pragma unroll
    for (int j = 0; j < 8; ++j) R.g[j] = gp[64 * j];
    nxt.s0 = slot_of[2 * tn]; nxt.s1 = slot_of[2 * tn + 1]; nxt.w0 = topw[2 * tn]; nxt.w1 = topw[2 * tn + 1];
    asm volatile("" ::: "memory");
#pragma unroll
    for (int j = 0; j < 8; ++j) R.x[j] = (f32x4){bflo(xb[j].x), bfhi(xb[j].x), bflo(xb[j].y), bfhi(xb[j].y)};
}
template <int YMODE, int HAS_H  , bool ROUTE, bool XB  >
__device__ __forceinline__ void row_finish(RowIn<YMODE, HAS_H>& R, int t, int lane, float* __restrict__ xout, bf16* __restrict__ hout, const LAS float* wrT, int* __restrict__ topi_out, float* __restrict__ topw_out) {
    f32x4 (&x)[8] = R.x;
    if constexpr (YMODE != 0) {
        f32x4 y[8];
#pragma unroll
        for (int j = 0; j < 8; ++j) { const v2u p = R.y0[j];
            if constexpr (YMODE == 1) y[j] = (f32x4){bflo(p.x), bfhi(p.x), bflo(p.y), bfhi(p.y)};
            else { const v2u q = R.y1[j]; const float w0 = R.w0, w1 = R.w1;
                y[j] = (f32x4){w0 * bflo(p.x) + w1 * bflo(q.x), w0 * bfhi(p.x) + w1 * bfhi(q.x), w0 * bflo(p.y) + w1 * bflo(q.y), w0 * bfhi(p.y) + w1 * bfhi(q.y)}; } }
        float ss = 0.f;
#pragma unroll
        for (int j = 0; j < 8; ++j) ss += (y[j].x * y[j].x + y[j].y * y[j].y) + (y[j].z * y[j].z + y[j].w * y[j].w);
        ss = wave_sum(ss);
        const float r = 1.0f / sqrtf(ss * (1.0f / DM) + EPS);
        f32x4* op = (f32x4*)(xout + (size_t)t * DM) + lane; v2u* opb = (v2u*)((bf16*)xout + (size_t)t * DM) + lane;
#pragma unroll
        for (int j = 0; j < 8; ++j) { x[j] = x[j] + R.g[j] * y[j] * r;
            if constexpr (XB) { v2u w; w.x = pk2(x[j].x, x[j].y); w.y = pk2(x[j].z, x[j].w); opb[64 * j] = w; } else __builtin_nontemporal_store(x[j], op + 64 * j); }
    }
    if constexpr (HAS_H != 0) {
        float ss = 0.f;
#pragma unroll
        for (int j = 0; j < 8; ++j) ss += (x[j].x * x[j].x + x[j].y * x[j].y) + (x[j].z * x[j].z + x[j].w * x[j].w);
        ss = wave_sum(ss);
        const float r = 1.0f / sqrtf(ss * (1.0f / DM) + EPS);
        v2u* hp = (v2u*)(hout + (size_t)t * DM) + lane; unsigned* hp8 = (unsigned*)((unsigned char*)hout + (size_t)t * DM) + lane;
#pragma unroll
        for (int j = 0; j < 8; ++j) { x[j] = x[j] * r * R.a[j] + R.s[j];
            if constexpr (HAS_H == 1) { v2u w; w.x = pk2(x[j].x, x[j].y); w.y = pk2(x[j].z, x[j].w); hp[64 * j] = w; }
            else { unsigned w = 0; w = __builtin_amdgcn_cvt_pk_fp8_f32(x[j].x, x[j].y, w, false); w = __builtin_amdgcn_cvt_pk_fp8_f32(x[j].z, x[j].w, w, true); hp8[64 * j] = w; } }
        if constexpr (ROUTE) {
            int i1 = 0, i2 = 0; float v1 = -3.0e38f, v2 = -3.0e38f;
#pragma unroll 1
            for (int e = 0; e < 8; ++e) { float acc = 0.f;
#pragma unroll
                for (int j = 0; j < 8; ++j) { const f32x4 w = *(const LAS f32x4*)(wrT + e * DM + lane * 4 + 256 * j); acc += (x[j].x * w.x + x[j].y * w.y) + (x[j].z * w.z + x[j].w * w.w); }
                const float val = wave_sum(acc);
                if (val > v1) { v2 = v1; i2 = i1; v1 = val; i1 = e; } else if (val > v2) { v2 = val; i2 = e; } }
            const float ex = expf(v2 - v1); const float w1 = 1.0f / (1.0f + ex), w2 = ex / (1.0f + ex);
            if (lane == 0) { topi_out[2 * t] = i1; topi_out[2 * t + 1] = i2; topw_out[2 * t] = w1; topw_out[2 * t + 1] = w2; }
        }
    }
}
#define ROW_LOOP(YM, HH, LOAD, FIN) do { const int _st = nb * NWAVES; for (int _t = bid * NWAVES + wave; _t < T; _t += _st) { RowIn<YM, HH> _A; LOAD(_A, _t); FIN(_A, _t); } } while (0)

__device__ __forceinline__ void ph_prep(const Args& a, int l, int bid, int nb, int tid) {
    bf16* qkv = (bf16*)(a.ws + WS_QKV);
    const float* cosA = (const float*)(a.ws + WS_ROPE); const float* sinA = cosA + 2048 * 64; const float* cosB = sinA + 2048 * 64; const float* sinB = cosB + 2048 * 64;
    const int wave = __builtin_amdgcn_readfirstlane(tid >> 6), lane = tid & 63;
    const int jA = (lane >> 5) * 32 + 2 * (lane & 15), jB = 2 * (lane & 31);
    const float sgA = (lane & 16) ? 1.f : -1.f, sgB = (lane & 32) ? 1.f : -1.f;
    const f32x2 gk = *(const f32x2*)(a.in[10] + l * HD + 2 * lane);
    const int st = nb * NWAVES;
    for (int t0 = bid * NWAVES + wave; t0 < T; t0 += 2 * st) {
        unsigned w[2][4]; f32x2 cA[2], sA[2], cB[2], sB[2]; unsigned* p[2][4]; const int nt = (t0 + st < T) ? 2 : 1;
#pragma unroll
        for (int q = 0; q < 2; ++q) { const int t = q < nt ? t0 + q * st : t0; const int pos = t & (SEQ - 1); bf16* row = qkv + (size_t)t * NQKV;
            p[q][0] = (unsigned*)(row + KA_OFF) + lane; p[q][1] = (unsigned*)(row + KA_OFF + HD) + lane; p[q][2] = (unsigned*)(row + KB_OFF) + lane; p[q][3] = (unsigned*)(row + KB_OFF + HD) + lane;
#pragma unroll
            for (int h = 0; h < 4; ++h) w[q][h] = *p[q][h];
            cA[q] = *(const f32x2*)(cosA + pos * 64 + jA); sA[q] = *(const f32x2*)(sinA + pos * 64 + jA); cB[q] = *(const f32x2*)(cosB + pos * 64 + jB); sB[q] = *(const f32x2*)(sinB + pos * 64 + jB); }
        asm volatile("" ::: "memory");
#pragma unroll
        for (int q = 0; q < 2; ++q) if (q < nt) {
#pragma unroll
            for (int h = 0; h < 2; ++h) {
                float x0 = bflo(w[q][h]), x1 = bfhi(w[q][h]);
                const float ss = wave_sum(x0 * x0 + x1 * x1); const float r = 1.0f / sqrtf(ss * (1.0f / HD) + EPS);
                x0 *= r * gk.x; x1 *= r * gk.y;
                const float p0 = __shfl_xor(x0, 16), p1 = __shfl_xor(x1, 16);
                *p[q][h] = pk2(x0 * cA[q].x + sgA * p0 * sA[q].x, x1 * cA[q].y + sgA * p1 * sA[q].y); }
#pragma unroll
            for (int h = 2; h < 4; ++h) {
                const float x0 = bflo(w[q][h]), x1 = bfhi(w[q][h]);
                const float p0 = __shfl_xor(x0, 32), p1 = __shfl_xor(x1, 32);
                *p[q][h] = pk2(x0 * cB[q].x + sgB * p0 * sB[q].x, x1 * cB[q].y + sgB * p1 * sB[q].y); }
        }
    }
}

__device__ __forceinline__ void ph_attn_norm(const Args& a, int bid, int nb, int tid) {
    const f32x4* ssq = (const f32x4*)(a.ws + WS_SSQ); f32x2* fac = (f32x2*)(a.ws + WS_FAC);
    for (int t = bid * NTHR + tid; t < T; t += nb * NTHR) {
        const f32x4 a0 = ssq[t * 4], a1 = ssq[t * 4 + 1], b0 = ssq[t * 4 + 2], b1 = ssq[t * 4 + 3];
        const float sa = ((a0.x + a0.y) + (a0.z + a0.w)) + ((a1.x + a1.y) + (a1.z + a1.w)), sb = ((b0.x + b0.y) + (b0.z + b0.w)) + ((b1.x + b1.y) + (b1.z + b1.w));
        fac[t] = (f32x2){1.0f / sqrtf(sa * (1.0f / 1024.f) + EPS), 1.0f / sqrtf(sb * (1.0f / 1024.f) + EPS)};
    }
}

__device__ __forceinline__ void ph_route_cnt(const Args& a, LAS unsigned char* lds, int bid, int nb, int tid) {
    const int* topi = (const int*)(a.ws + WS_TOPI); int* cnt = (int*)(a.ws + WS_CNT);
    LAS int* cn = (LAS int*)lds;
    for (int c = bid; c < 256; c += nb) {
        if (tid < 8) cn[tid] = 0;
        __syncthreads();
        if (tid < 256) atomicAdd((int*)&cn[topi[c * 256 + tid]], 1);
        __syncthreads();
        if (tid < 8) cnt[c * 8 + tid] = cn[tid];
        __syncthreads();
    }
}
__device__ __forceinline__ void ph_route_build(const Args& a, LAS unsigned char* lds, int bid, int nb, int tid) {
    const int* topi = (const int*)(a.ws + WS_TOPI); const int* cnt = (const int*)(a.ws + WS_CNT);
    int* rowl = (int*)(a.ws + WS_ROWL); int* slot = (int*)(a.ws + WS_SLOT); int* tile = (int*)(a.ws + WS_TILE);
    LAS int* sh = (LAS int*)lds;
    LAS int* scnt = sh + 32;
    LAS int* stop = scnt + 2048;
    for (int c = bid; c < 256; c += nb) {
        for (int i = tid; i < 2048; i += NTHR) scnt[i] = cnt[i];
        if (tid < 256) stop[tid] = topi[c * 256 + tid];
        __syncthreads();
        if (tid < 8) { int tot = 0, base = 0; for (int cc = 0; cc < 256; ++cc) { const int v = scnt[cc * 8 + tid]; if (cc < c) base += v; tot += v; } sh[tid] = tot; sh[8 + tid] = base; }
        __syncthreads();
        if (tid == 0) { int o = 0; for (int e = 0; e < 8; ++e) { sh[16 + e] = o; o += (sh[e] + 255) & ~255; } sh[24] = o; }
        __syncthreads();
        if (tid < 8) { int pos = sh[16 + tid] + sh[8 + tid];
            for (int i = 0; i < 256; ++i) if (stop[i] == tid) { rowl[pos] = c * 128 + (i >> 1); slot[c * 256 + i] = pos; ++pos; } }
        if (c < 8) { const int tot = sh[c], o = sh[16 + c], padded = (tot + 255) & ~255;
            for (int i = tid; i < padded - tot; i += NTHR) rowl[o + tot + i] = 0;
            for (int i = tid; i < padded / 256; i += NTHR) tile[o / 256 + i] = c; }
        if (c == 0 && tid == 0) tile[512] = sh[24] / 256;
        __syncthreads();
    }
}


namespace pg8 {
constexpr int BM = 256, BK = 64, HALF = 128, HTB = HALF * BK * 2, STAGE_BYTES = 8 * HTB, NXCD = 8;
__host__ __device__ __forceinline__ int lds_byte(int r, int c) { const int st = (r >> 4) * 2 + (c >> 5), rr = r & 15, cc = c & 31, ob = rr * 64 + cc * 2; return st * 1024 + (ob ^ (((ob >> 9) & 1) << 5)); }
__host__ __device__ __forceinline__ void stage_rc(int b, int& R, int& C) { const int st = b / 1024, sb = b % 1024, swz = sb ^ (((sb >> 9) & 1) << 5); R = (st >> 1) * 16 + swz / 64; C = (st & 1) * 32 + (swz % 64) / 2; }
__host__ __device__ __forceinline__ int perm32(int rho) { const int n = rho >> 4, i = rho & 15; return 8 * (i >> 2) + 4 * n + (i & 3); }
struct Unit { int pm, pn; };
struct StaticOrder {
    int nM, nN, nwg, G, c, WGM = 4, r0 = 0, r1 = 1 << 30;
    __device__ void init(int nM_, int nN_, int G_, int c_, int wgm = 4) { nM = nM_; nN = nN_; nwg = nM * nN; G = G_; c = c_; WGM = wgm; }
    __device__ bool next(int i_, Unit& u) const {
        const int i = i_ + r0; if (i >= r1) return false;
        const long L = (long)i * G + c; if (L >= nwg) return false;
        int wgid = (int)L; { const int q = nwg / NXCD, r = nwg % NXCD, xcd = wgid % NXCD, off = wgid / NXCD; wgid = (xcd < r ? xcd * (q + 1) : r * (q + 1) + (xcd - r) * q) + off; }
        const int nig = WGM * nN, gid = wgid / nig, fm = gid * WGM, gsz = (nM - fm) < WGM ? (nM - fm) : WGM;
        u.pm = fm + ((wgid % nig) % gsz); u.pn = (wgid % nig) / gsz; return true;
    }
};
__device__ __forceinline__ unsigned cvt_pk_bf16(float lo, float hi) { unsigned r; asm volatile("v_cvt_pk_bf16_f32 %0, %1, %2" : "=v"(r) : "v"(lo), "v"(hi)); return r; }
struct EpiPlain {
    static constexpr bool MID = false;
    bf16* O; int ldc; float sc;
    __device__ __forceinline__ void operator()(const f32x4 (&acc)[2][2][4][2], const Unit& u, int wr, int wc, int fr, int fq) const {
        const int row0 = u.pm * BM + wr * 64 + fr, col0 = u.pn * BM + wc * 32 + 8 * fq;
#pragma unroll
        for (int ai = 0; ai < 2; ++ai)
#pragma unroll
            for (int m = 0; m < 4; ++m) { bf16* rowp = O + (size_t)(row0 + ai * HALF + m * 16) * ldc + col0;
#pragma unroll
                for (int bj = 0; bj < 2; ++bj) { const f32x4 v0 = acc[ai][bj][m][0] * sc, v1 = acc[ai][bj][m][1] * sc;
                    v4u w; w.x = cvt_pk_bf16(v0[0], v0[1]); w.y = cvt_pk_bf16(v0[2], v0[3]); w.z = cvt_pk_bf16(v1[0], v1[1]); w.w = cvt_pk_bf16(v1[2], v1[3]);
                    *(v4u*)(rowp + bj * HALF) = w; } }
    }
};
struct EpiRowScale {
    static constexpr bool MID = true;
    bf16* O; int ldc; const float* fac;
    __device__ __forceinline__ void operator()(const f32x4 (&acc)[2][2][4][2], const Unit& u, int wr, int wc, int fr, int fq, const float (&fw)[2][4]) const {
        const int row0 = u.pm * BM + wr * 64 + fr, col0 = u.pn * BM + wc * 32 + 8 * fq;
#pragma unroll
        for (int ai = 0; ai < 2; ++ai)
#pragma unroll
            for (int m = 0; m < 4; ++m) { bf16* rowp = O + (size_t)(row0 + ai * HALF + m * 16) * ldc + col0; const float sc = fw[ai][m];
#pragma unroll
                for (int bj = 0; bj < 2; ++bj) { const f32x4 v0 = acc[ai][bj][m][0] * sc, v1 = acc[ai][bj][m][1] * sc;
                    v4u w; w.x = cvt_pk_bf16(v0[0], v0[1]); w.y = cvt_pk_bf16(v0[2], v0[3]); w.z = cvt_pk_bf16(v1[0], v1[1]); w.w = cvt_pk_bf16(v1[2], v1[3]);
                    *(v4u*)(rowp + bj * HALF) = w; } }
    }
};
__device__ __forceinline__ float silu_mul(float g, float u) { return g * __builtin_amdgcn_rcpf(1.0f + __builtin_amdgcn_exp2f(-1.4426950408889634f * g)) * u; }
struct EpiSwiglu {
    static constexpr bool MID = false;
    bf16* O; int ldc;
    __device__ __forceinline__ void operator()(const f32x4 (&acc)[2][2][4][2], const Unit& u, int wr, int wc, int fr, int fq) const {
        const int row0 = u.pm * BM + wr * 64 + fr, col0 = u.pn * HALF + wc * 32 + 8 * fq;
#pragma unroll
        for (int ai = 0; ai < 2; ++ai)
#pragma unroll
            for (int m = 0; m < 4; ++m) { bf16* rowp = O + (size_t)(row0 + ai * HALF + m * 16) * ldc + col0;
                const f32x4 g0 = acc[ai][0][m][0], g1 = acc[ai][0][m][1], u0 = acc[ai][1][m][0], u1 = acc[ai][1][m][1];
                v4u w; w.x = cvt_pk_bf16(silu_mul(g0[0], u0[0]), silu_mul(g0[1], u0[1])); w.y = cvt_pk_bf16(silu_mul(g0[2], u0[2]), silu_mul(g0[3], u0[3]));
                w.z = cvt_pk_bf16(silu_mul(g1[0], u1[0]), silu_mul(g1[1], u1[1])); w.w = cvt_pk_bf16(silu_mul(g1[2], u1[2]), silu_mul(g1[3], u1[3]));
                *(v4u*)rowp = w; }
    }
};
struct EpiSwiglu8 {
    static constexpr bool MID = false;
    unsigned char* O; int ldc; float sc;
    static __device__ __forceinline__ f32x4 swiglu4(f32x4 g, f32x4 u, float kk, float c2) {
        const f32x4 t = g * u, x = g * kk; f32x4 e, r;
#pragma unroll
        for (int i = 0; i < 4; ++i) e[i] = __builtin_amdgcn_exp2f(x[i]);
        const f32x4 d = e * c2 + c2;
#pragma unroll
        for (int i = 0; i < 4; ++i) r[i] = __builtin_amdgcn_rcpf(d[i]);
        return t * r;
    }
    __device__ __forceinline__ void operator()(const f32x4 (&acc)[2][2][4][2], const Unit& u, int wr, int wc, int fr, int fq) const {
        const int row0 = u.pm * BM + wr * 64 + fr + (fq & 1) * 16, col0 = u.pn * HALF + wc * 32 + 8 * (fq & 2);
        const float kk = -1.4426950408889634f * sc, c2 = 1.0f / (sc * sc);
#pragma unroll
        for (int ai = 0; ai < 2; ++ai)
#pragma unroll
            for (int mp = 0; mp < 4; mp += 2) { v2u w[2];
#pragma unroll
                for (int q = 0; q < 2; ++q) { const int m = mp + q;
                    const f32x4 o0 = swiglu4(acc[ai][0][m][0], acc[ai][1][m][0], kk, c2), o1 = swiglu4(acc[ai][0][m][1], acc[ai][1][m][1], kk, c2);
                    w[q].x = 0; w[q].y = 0;
                    w[q].x = __builtin_amdgcn_cvt_pk_fp8_f32(o0[0], o0[1], w[q].x, false); w[q].x = __builtin_amdgcn_cvt_pk_fp8_f32(o0[2], o0[3], w[q].x, true);
                    w[q].y = __builtin_amdgcn_cvt_pk_fp8_f32(o1[0], o1[1], w[q].y, false); w[q].y = __builtin_amdgcn_cvt_pk_fp8_f32(o1[2], o1[3], w[q].y, true); }
                const auto rx = __builtin_amdgcn_permlane16_swap(w[0].x, w[1].x, false, false), ry = __builtin_amdgcn_permlane16_swap(w[0].y, w[1].y, false, false);
                v4u o; o.x = rx[0]; o.y = ry[0]; o.z = rx[1]; o.w = ry[1];
                *(v4u*)(O + (size_t)(row0 + ai * HALF + mp * 16) * ldc + col0) = o; }
    }
};
typedef int i32x8 __attribute__((ext_vector_type(8)));
typedef int i32x4 __attribute__((ext_vector_type(4)));
typedef short bf16x16 __attribute__((ext_vector_type(16)));
__device__ __forceinline__ i32x8 cat8(bf16x8 lo, bf16x8 hi) { const i32x4 a = __builtin_bit_cast(i32x4, lo), b = __builtin_bit_cast(i32x4, hi); return (i32x8){a[0], a[1], a[2], a[3], b[0], b[1], b[2], b[3]}; }
template <class Epi, bool GATHER, bool EXPERT, bool FP8 = false>
__device__ __forceinline__ void gemm_phase(LAS unsigned char* lds, const char* Abase, const int* rowlist, const char* Bbase, const int* tile_expert, size_t bstride_e, int Kelems, const StaticOrder& S, const Epi& E) {
    const int K = FP8 ? Kelems / 2 : Kelems;
    const int tid = fresh_tid(), wid = __builtin_amdgcn_readfirstlane(tid >> 6), lane = tid & 63, wr = wid >> 2, wc = wid & 3, fr = lane & 15, fq = lane >> 4;
    const int nt = K / BK;
    unsigned voffA[2], voffB[2];
#pragma unroll
    for (int i = 0; i < 2; ++i) { int R, C; stage_rc(tid * 16 + i * 8192, R, C); const int Rb = (R & ~31) + perm32(R & 31);
        voffA[i] = GATHER ? (unsigned)(R * 65536 + C * 2) : (unsigned)(R * K + C) * 2u; voffB[i] = (unsigned)(Rb * K + C) * 2u; }
    const size_t kstep = (size_t)(BK * 2), hstep = (size_t)HALF * K * 2, tstep = 2 * hstep;
    const unsigned ldsw = (unsigned)wid * 1024u;
    const int aoff = lds_byte(wr * 64 + fr, fq * 8), boff = lds_byte(wc * 32 + fr, fq * 8);
    LAS unsigned* rtab = (LAS unsigned*)(lds + STAGE_BYTES + 1024);
    LAS int* etab = (LAS int*)(lds + STAGE_BYTES + 4096);
    LAS float* ftab = (LAS float*)(lds + STAGE_BYTES + 8192);
    const unsigned rowbytes = (unsigned)K * 2u;
#define PG8_SA(b, h) (((b) * 2 + (h)) * HTB)
#define PG8_SB(b, h) ((4 + (b) * 2 + (h)) * HTB)
#define PG8_STAGE(bufoff, gbase, voff) do { _Pragma("unroll") for (int _i = 0; _i < 2; ++_i) { asm volatile("" : "+v"((voff)[_i])); \
        __builtin_amdgcn_global_load_lds((const unsigned*)((const char*)(gbase) + (voff)[_i]), (LAS unsigned*)(lds + (bufoff) + ldsw + _i * 8192), 16, 0, 0); } } while (0)
#define PG8_STAGE_A(bufoff, pa, par, kb, h) do { _Pragma("unroll") for (int _i = 0; _i < 2; ++_i) { if constexpr (GATHER) asm volatile("" : "+v"(ra[h][_i])); else asm volatile("" : "+v"(voffA[_i])); \
        const char* _p = GATHER ? Abase + (kb) + ra[h][_i] : (pa) + (kb) + (size_t)(h) * hstep + voffA[_i]; \
        __builtin_amdgcn_global_load_lds((const unsigned*)_p, (LAS unsigned*)(lds + (bufoff) + ldsw + _i * 8192), 16, 0, 0); } } while (0)
#define PG8_LDA(dst, b, h) do { _Pragma("unroll") for (int m = 0; m < 4; ++m) { const bf16x8 _l = *(const LAS bf16x8*)(lds + PG8_SA(b, h) + aoff + m * 2048), _h = *(const LAS bf16x8*)(lds + PG8_SA(b, h) + aoff + m * 2048 + 1024); \
        dst[m] = __builtin_shufflevector(_l, _h, 0, 1, 2, 3, 4, 5, 6, 7, 8, 9, 10, 11, 12, 13, 14, 15); } } while (0)
#define PG8_LDB(dst, b, h) do { _Pragma("unroll") for (int n = 0; n < 2; ++n) { const bf16x8 _l = *(const LAS bf16x8*)(lds + PG8_SB(b, h) + boff + n * 2048), _h = *(const LAS bf16x8*)(lds + PG8_SB(b, h) + boff + n * 2048 + 1024); \
        dst[n] = __builtin_shufflevector(_l, _h, 0, 1, 2, 3, 4, 5, 6, 7, 8, 9, 10, 11, 12, 13, 14, 15); } } while (0)
#define PG8_HALF(v, k) __builtin_shufflevector(v, v, 8 * (k), 8 * (k) + 1, 8 * (k) + 2, 8 * (k) + 3, 8 * (k) + 4, 8 * (k) + 5, 8 * (k) + 6, 8 * (k) + 7)
#define PG8_MMA(ai, bj, At, Bt) do { __builtin_amdgcn_s_setprio(1); _Pragma("unroll") for (int m = 0; m < 4; ++m) _Pragma("unroll") for (int n = 0; n < 2; ++n) { \
        if constexpr (FP8) asm volatile("v_mfma_f32_16x16x128_f8f6f4 %0, %1, %2, %0" : "+v"(acc[ai][bj][m][n]) : "v"(__builtin_bit_cast(i32x8, Bt[n])), "v"(__builtin_bit_cast(i32x8, At[m]))); \
        else { acc[ai][bj][m][n] = __builtin_amdgcn_mfma_f32_16x16x32_bf16(PG8_HALF(Bt[n], 0), PG8_HALF(At[m], 0), acc[ai][bj][m][n], 0, 0, 0); \
               acc[ai][bj][m][n] = __builtin_amdgcn_mfma_f32_16x16x32_bf16(PG8_HALF(Bt[n], 1), PG8_HALF(At[m], 1), acc[ai][bj][m][n], 0, 0, 0); } } \
        __builtin_amdgcn_s_setprio(0); } while (0)
#define PG8_WAIT_V(n) asm volatile("s_waitcnt vmcnt(" #n ")" ::: "memory")
#define PG8_WAIT_L(n) asm volatile("s_waitcnt lgkmcnt(" #n ")" ::: "memory")
#define PG8_BAR __builtin_amdgcn_s_barrier()
#define PG8_SCHED __builtin_amdgcn_sched_barrier(0)
#define PG8_RTAB(par, u) do { if (GATHER && wid < 4) __builtin_amdgcn_global_load_lds((const unsigned*)(rowlist + (u).pm * BM + wid * 64 + lane), (LAS unsigned*)(rtab + (par) * 256 + wid * 64), 4, 0, 0); } while (0)
#define PG8_FTAB(par, u) do { if constexpr (Epi::MID) __builtin_amdgcn_global_load_lds((const unsigned*)(E.fac + (size_t)(u).pm * BM * 2 + wid * 64 + lane), (LAS unsigned*)(ftab + (par) * 512 + wid * 64), 4, 0, 0); } while (0)
#define PG8_RA(par) do { if constexpr (GATHER) { _Pragma("unroll") for (int _h = 0; _h < 2; ++_h) _Pragma("unroll") for (int _i = 0; _i < 2; ++_i) \
        ra[_h][_i] = rtab[(par) * 256 + _h * HALF + (voffA[_i] >> 16)] * rowbytes + (voffA[_i] & 0xffffu); } } while (0)
#define PG8_BPTR(u) (Bbase + (EXPERT ? (size_t)__builtin_amdgcn_readfirstlane(etab[(u).pm]) * bstride_e : (size_t)0) + (size_t)(u).pn * tstep)
    Unit cur, nxt; int ui = 0;
    if (!S.next(0, cur)) return;
    f32x4 acc[2][2][4][2];
#pragma unroll
    for (int a = 0; a < 2; ++a)
#pragma unroll
        for (int b = 0; b < 2; ++b)
#pragma unroll
            for (int m = 0; m < 4; ++m)
#pragma unroll
                for (int n = 0; n < 2; ++n) acc[a][b][m][n] = (f32x4){0.f, 0.f, 0.f, 0.f};
    bf16x16 At[4], B0[2], B1[2];
    if (EXPERT) etab[tid] = tile_expert[tid];
    float fwr[2][4] = {};
    unsigned ra[2][2] = {};
    if (GATHER || EXPERT || Epi::MID) { PG8_RTAB(0, cur); PG8_FTAB(0, cur); asm volatile("s_waitcnt vmcnt(0) lgkmcnt(0)" ::: "memory"); __syncthreads(); }
    PG8_RA(0);
    const char* cA = Abase + (GATHER ? (size_t)0 : (size_t)cur.pm * tstep); const char* cB = PG8_BPTR(cur);
    PG8_STAGE(PG8_SB(0, 0), cB, voffB); PG8_STAGE(PG8_SB(0, 1), cB + hstep, voffB); PG8_STAGE_A(PG8_SA(0, 0), cA, 0, 0, 0); PG8_STAGE_A(PG8_SA(0, 1), cA, 0, 0, 1);
    if (wr == 1) PG8_BAR;
    PG8_WAIT_V(2); PG8_BAR;
    PG8_STAGE(PG8_SB(1, 0), cB + kstep, voffB); PG8_STAGE_A(PG8_SA(1, 0), cA, 0, kstep, 0); PG8_STAGE(PG8_SB(1, 1), cB + hstep + kstep, voffB);
    PG8_WAIT_V(6); PG8_BAR;
    for (;;) {
        const bool has_next = S.next(ui + 1, nxt);
        const int pc = ui & 1, pn_ = has_next ? (pc ^ 1) : pc;
        if (has_next) { PG8_RTAB(pc ^ 1, nxt); PG8_FTAB(pc ^ 1, nxt); }
        const char* nA = GATHER ? Abase : (has_next ? Abase + (size_t)nxt.pm * tstep : cA); const char* nB = has_next ? PG8_BPTR(nxt) : cB;
        for (int t = 0; t < nt; t += 2) {
            const bool last = (t == nt - 2);
            if constexpr (Epi::MID) { if (t == (nt >> 1)) {
#pragma unroll
                for (int ai = 0; ai < 2; ++ai)
#pragma unroll
                    for (int m = 0; m < 4; ++m) { const f32x2 f = *(const LAS f32x2*)(ftab + pc * 512 + (ai * HALF + wr * 64 + m * 16 + fr) * 2); const float ratio = f.x / f.y; fwr[ai][m] = f.y;
#pragma unroll
                        for (int bj = 0; bj < 2; ++bj)
#pragma unroll
                            for (int n = 0; n < 2; ++n) acc[ai][bj][m][n] *= ratio; } } }
            const size_t k1 = (size_t)(t + 1) * kstep, k2 = last ? (size_t)0 : (size_t)(t + 2) * kstep, k3 = k2 + kstep;
            const char* a2 = last ? nA : cA; const int p2 = last ? pn_ : pc;
            const char* b2 = last ? nB : cB + (size_t)(t + 2) * kstep; const char* b3 = b2 + kstep;
            PG8_LDB(B0, 0, 0); PG8_LDB(B1, 0, 1); PG8_SCHED; PG8_LDA(At, 0, 0); PG8_STAGE_A(PG8_SA(1, 1), cA, pc, k1, 1);
            if constexpr (GATHER) { if (last) PG8_RA(pn_); }
            PG8_WAIT_V(8); PG8_WAIT_L(0); PG8_BAR; PG8_MMA(0, 0, At, B0); PG8_MMA(0, 1, At, B1); PG8_BAR; PG8_SCHED;
            PG8_LDA(At, 0, 1); PG8_STAGE(PG8_SB(0, 0), b2, voffB); PG8_STAGE(PG8_SB(0, 1), b2 + hstep, voffB); PG8_STAGE_A(PG8_SA(0, 0), a2, p2, k2, 0);
            PG8_WAIT_V(8); PG8_WAIT_L(0); PG8_BAR; PG8_MMA(1, 0, At, B0); PG8_MMA(1, 1, At, B1); PG8_BAR; PG8_SCHED;
            PG8_LDB(B0, 1, 0); PG8_LDB(B1, 1, 1); PG8_SCHED; PG8_LDA(At, 1, 0); PG8_STAGE_A(PG8_SA(0, 1), a2, p2, k2, 1);
            PG8_WAIT_V(8); PG8_WAIT_L(0); PG8_BAR; PG8_MMA(0, 0, At, B0); PG8_MMA(0, 1, At, B1); PG8_BAR; PG8_SCHED;
            PG8_LDA(At, 1, 1); PG8_STAGE(PG8_SB(1, 0), b3, voffB); PG8_STAGE(PG8_SB(1, 1), b3 + hstep, voffB); PG8_STAGE_A(PG8_SA(1, 0), a2, p2, k3, 0);
            PG8_WAIT_V(8); PG8_WAIT_L(0); PG8_BAR; PG8_MMA(1, 0, At, B0); PG8_MMA(1, 1, At, B1); PG8_BAR; PG8_SCHED;
        }
        if (wr == 0) PG8_BAR;
        if constexpr (FP8) asm volatile("s_nop 15\n\ts_nop 15" ::: "memory");
        if constexpr (Epi::MID) E(acc, cur, wr, wc, fr, fq, fwr); else E(acc, cur, wr, wc, fr, fq);
        if (!has_next) break;
#pragma unroll
        for (int a = 0; a < 2; ++a)
#pragma unroll
            for (int b = 0; b < 2; ++b)
#pragma unroll
                for (int m = 0; m < 4; ++m)
#pragma unroll
                    for (int n = 0; n < 2; ++n) acc[a][b][m][n] = (f32x4){0.f, 0.f, 0.f, 0.f};
        cur = nxt; cA = nA; cB = nB; ++ui;
        if (wr == 1) PG8_BAR;
    }
    PG8_WAIT_V(0);
    PG8_BAR;
#undef PG8_SA
#undef PG8_SB
#undef PG8_STAGE
#undef PG8_STAGE_A
#undef PG8_LDA
#undef PG8_LDB
#undef PG8_MMA
#undef PG8_HALF
#undef PG8_WAIT_V
#undef PG8_WAIT_L
#undef PG8_BAR
#undef PG8_SCHED
#undef PG8_RTAB
#undef PG8_BPTR
#undef PG8_RA
#undef PG8_FTAB
}
}


namespace att {
constexpr int D = 128, NW = 8, QBLK = 32, KVBLK = 64;
constexpr float SCALE = 0.088388347648318440f, THR = 8.f;
constexpr int LDQ = NQKV, LDK = NQKV, LDO = DM;
constexpr size_t SHM_V = KVBLK * D * 2, SHM_K = KVBLK * D * 2, SHM_ATTN = 2 * SHM_V + 2 * SHM_K + NW * 64 * 4;
using s16x4 = __attribute__((ext_vector_type(4))) short;
#define KSWZ(row, colB) ((row) * 256 + ((colB) ^ (((row) & 7) << 4)))
#define SBAR() __builtin_amdgcn_sched_barrier(0)
__device__ __forceinline__ int crow(int r, int hi) { return (r & 3) + 8 * (r >> 2) + 4 * hi; }
__device__ __forceinline__ unsigned cvtpk(float lo, float hi) { unsigned r; asm volatile("v_cvt_pk_bf16_f32 %0, %1, %2" : "=v"(r) : "v"(lo), "v"(hi)); return r; }
template <bool WIN>
__device__ __forceinline__ void partialSM(f32x16& p0, f32x16& p1, float& m_reg, float& mn, float& alpha, int kq, int hi) {
  constexpr float C = SCALE * 1.4426950408889634f;
  if constexpr (WIN) {
#pragma unroll
    for (int r = 0; r < 16; ++r) { const int d0 = kq + crow(r, hi), d1 = d0 + 32; if (d0 < -128 || d0 > 128) p0[r] = -1.0e30f; if (d1 < -128 || d1 > 128) p1[r] = -1.0e30f; }
  }
  float pmax = p0[0];
#pragma unroll
  for (int r = 1; r < 16; ++r) pmax = fmaxf(pmax, p0[r]);
#pragma unroll
  for (int r = 0; r < 16; ++r) pmax = fmaxf(pmax, p1[r]);
  { auto rr = __builtin_amdgcn_permlane32_swap(__float_as_uint(pmax), __float_as_uint(pmax), false, false);
    pmax = fmaxf(__uint_as_float(rr[0]), __uint_as_float(rr[1])); }
  if (__builtin_expect(__all(pmax - m_reg <= THR / SCALE), 1)) { mn = m_reg; alpha = 1.f; }
  else { mn = fmaxf(m_reg, pmax); alpha = __builtin_amdgcn_exp2f((m_reg - mn) * C); m_reg = mn; }
  const float mnC = -mn * C;
#pragma unroll
  for (int r = 0; r < 16; ++r) p0[r] = fmaf(p0[r], C, mnC);
#pragma unroll
  for (int r = 0; r < 16; ++r) p1[r] = fmaf(p1[r], C, mnC);
#pragma unroll
  for (int r = 0; r < 16; ++r) p0[r] = __builtin_amdgcn_exp2f(p0[r]);
}
__device__ __forceinline__ void finishSM(f32x16& p0, f32x16& p1, float alpha, float& l_reg, bf16x8& pa0, bf16x8& pa1, bf16x8& pa2, bf16x8& pa3) {
#pragma unroll
  for (int r = 0; r < 16; ++r) p1[r] = __builtin_amdgcn_exp2f(p1[r]);
  float ps = 0;
#pragma unroll
  for (int r = 0; r < 16; ++r) ps += p0[r];
#pragma unroll
  for (int r = 0; r < 16; ++r) ps += p1[r];
  { auto rr = __builtin_amdgcn_permlane32_swap(__float_as_uint(ps), __float_as_uint(ps), false, false);
    ps = __uint_as_float(rr[0]) + __uint_as_float(rr[1]); }
  l_reg = l_reg * alpha + ps;
#define PK4(P, BASE, OUT) do { unsigned a0 = cvtpk(P[BASE + 0], P[BASE + 1]), a1 = cvtpk(P[BASE + 2], P[BASE + 3]);   \
    unsigned b0 = cvtpk(P[BASE + 4], P[BASE + 5]), b1 = cvtpk(P[BASE + 6], P[BASE + 7]);                              \
    auto r0 = __builtin_amdgcn_permlane32_swap(a0, b0, false, false); auto r1 = __builtin_amdgcn_permlane32_swap(a1, b1, false, false); \
    v4u w = {r0[0], r1[0], r0[1], r1[1]}; OUT = *reinterpret_cast<bf16x8*>(&w); } while (0)
  PK4(p0, 0, pa0); PK4(p0, 8, pa1); PK4(p1, 0, pa2); PK4(p1, 8, pa3);
#undef PK4
}
__device__ __forceinline__ void qkt(f32x16& p0, f32x16& p1, const bf16* Ks, const bf16x8* qr, int r32, int hi) {
  p0 = f32x16{}; p1 = f32x16{};
#pragma unroll
  for (int d0 = 0; d0 < 8; ++d0) { const int cb = (d0 * 16 + hi * 8) * 2;
    const bf16x8 b0 = *reinterpret_cast<const bf16x8*>((const char*)Ks + KSWZ(r32, cb));
    const bf16x8 b1 = *reinterpret_cast<const bf16x8*>((const char*)Ks + KSWZ(32 + r32, cb));
    p0 = __builtin_amdgcn_mfma_f32_32x32x16_bf16(b0, qr[d0], p0, 0, 0, 0);
    p1 = __builtin_amdgcn_mfma_f32_32x32x16_bf16(b1, qr[d0], p1, 0, 0, 0); }
}
__device__ __forceinline__ int v_st(int k, int c) { const int kk = (k & ~0xC) | ((k & 4) << 1) | ((k & 8) >> 1); return ((kk >> 3) * 4 + (c >> 5)) * 512 + ((kk & 7) * 32 + (c & 31)) * 2; }
__device__ __forceinline__ int v_rd_base(int lane) { return ((lane & 3) << 3) | (((lane >> 2) & 3) << 6) | (((lane >> 4) & 1) << 5) | (((lane >> 5) & 1) << 8); }
constexpr int v_rd_off(int d0, int ks, int half) { return d0 * 512 + ks * 4096 + half * 2048; }
template <int OFF> __device__ __forceinline__ s16x4 tr_read(int vb) {
  s16x4 r; asm volatile("ds_read_b64_tr_b16 %0, %1 offset:%2" : "=&v"(r) : "v"(vb), "i"(OFF) : "memory"); return r;
}
template <int D0> __device__ __forceinline__ void pv_one(f32x16& od, int vb, bf16x8 pa0, bf16x8 pa1, bf16x8 pa2, bf16x8 pa3) {
  const s16x4 l0 = tr_read<v_rd_off(D0, 0, 0)>(vb), h0 = tr_read<v_rd_off(D0, 0, 1)>(vb), l1 = tr_read<v_rd_off(D0, 1, 0)>(vb), h1 = tr_read<v_rd_off(D0, 1, 1)>(vb);
  const s16x4 l2 = tr_read<v_rd_off(D0, 2, 0)>(vb), h2 = tr_read<v_rd_off(D0, 2, 1)>(vb), l3 = tr_read<v_rd_off(D0, 3, 0)>(vb), h3 = tr_read<v_rd_off(D0, 3, 1)>(vb);
  asm volatile("s_waitcnt lgkmcnt(0)" ::: "memory"); SBAR();
#define PK(L, H) (bf16x8){L[0], L[1], L[2], L[3], H[0], H[1], H[2], H[3]}
  od = __builtin_amdgcn_mfma_f32_32x32x16_bf16(pa0, PK(l0, h0), od, 0, 0, 0);
  od = __builtin_amdgcn_mfma_f32_32x32x16_bf16(pa1, PK(l1, h1), od, 0, 0, 0);
  od = __builtin_amdgcn_mfma_f32_32x32x16_bf16(pa2, PK(l2, h2), od, 0, 0, 0);
  od = __builtin_amdgcn_mfma_f32_32x32x16_bf16(pa3, PK(l3, h3), od, 0, 0, 0);
#undef PK
}
__device__ __forceinline__ void pv_d0(f32x16* o, int vb, bf16x8 pa0, bf16x8 pa1, bf16x8 pa2, bf16x8 pa3) {
  pv_one<0>(o[0], vb, pa0, pa1, pa2, pa3); pv_one<1>(o[1], vb, pa0, pa1, pa2, pa3); pv_one<2>(o[2], vb, pa0, pa1, pa2, pa3); pv_one<3>(o[3], vb, pa0, pa1, pa2, pa3);
}
template <bool WIN>
__device__ __forceinline__ void attn_unit(const bf16* __restrict__ Qb, const bf16* __restrict__ Kh, const bf16* __restrict__ Vh, bf16* __restrict__ Ob, int seq, int kq0, const float* __restrict__ m0p,
                                          const float* __restrict__ qg, const float* __restrict__ cosT, const float* __restrict__ sinT, int qpos0, float* __restrict__ Sp, char* lds) {
  const int tid = fresh_tid(), wid = __builtin_amdgcn_readfirstlane(tid >> 6), lane = tid & 63, r32 = lane & 31, hi = lane >> 5;
  bf16* V_lds = (bf16*)lds; bf16* K_lds = (bf16*)(lds + 2 * SHM_V);
  float* ws = (float*)(lds + 2 * SHM_V + 2 * SHM_K) + wid * 64; float* li_l = ws; float* al_l = ws + 32;
  const int wrow = WIN ? (wid & 3) * QBLK : wid * QBLK, wcol = WIN ? (wid >> 2) * D : 0;
  float m_reg = -1e30f, l_reg = 0.f; bf16x8 qr[8];
  if constexpr (WIN) { m_reg = m0p[wid >> 2] * (1.0f / SCALE); l_reg = 1.f; }
  const int kqw = kq0 - (wrow + r32);
  const int tlo_k = wrow - 128 - kq0, thi_k = wrow + 159 - kq0;
#ifndef WIN_SKIP
#define WIN_SKIP 0
#endif
#define NEED(t) (!WIN || !WIN_SKIP || (((t) * KVBLK + KVBLK - 1 >= tlo_k) && ((t) * KVBLK <= thi_k)))
  {
    const bf16* Qw = Qb + (long)(wrow + r32) * LDQ + wcol + hi * 8;
    float x[8][8];
#pragma unroll
    for (int d0 = 0; d0 < 8; ++d0) { const v4u w = *reinterpret_cast<const v4u*>(Qw + d0 * 16);
#pragma unroll
      for (int i = 0; i < 4; ++i) { x[d0][2 * i] = bflo(w[i]); x[d0][2 * i + 1] = bfhi(w[i]); } }
    const int pos = qpos0 + wrow + r32;
    if constexpr (!WIN) {
      float ss = 0.f;
#pragma unroll
      for (int d0 = 0; d0 < 8; ++d0)
#pragma unroll
        for (int e = 0; e < 8; ++e) ss += x[d0][e] * x[d0][e];
      ss += __shfl_xor(ss, 32);
      const float r = 1.0f / sqrtf(ss * (1.0f / D) + 1e-6f);
#pragma unroll
      for (int d0 = 0; d0 < 8; ++d0) { const f32x4 g0 = *(const f32x4*)(qg + d0 * 16 + hi * 8), g1 = *(const f32x4*)(qg + d0 * 16 + hi * 8 + 4);
#pragma unroll
        for (int e = 0; e < 4; ++e) { x[d0][e] *= r * g0[e]; x[d0][4 + e] *= r * g1[e]; } }
    }
#pragma unroll
    for (int pr = 0; pr < 4; ++pr) {
      const int a = WIN ? pr : ((pr >> 1) * 4 + (pr & 1)), b = WIN ? pr + 4 : a + 2;
      const int j0 = WIN ? (pr * 16 + hi * 8) : ((pr >> 1) * 32 + (pr & 1) * 16 + hi * 8);
      const f32x4 c0 = *(const f32x4*)(cosT + pos * 64 + j0), c1 = *(const f32x4*)(cosT + pos * 64 + j0 + 4), s0 = *(const f32x4*)(sinT + pos * 64 + j0), s1 = *(const f32x4*)(sinT + pos * 64 + j0 + 4);
#pragma unroll
      for (int e = 0; e < 8; ++e) { const float c = e < 4 ? c0[e & 3] : c1[e & 3], s = e < 4 ? s0[e & 3] : s1[e & 3]; const float xa = x[a][e], xb = x[b][e];
        x[a][e] = xa * c - xb * s; x[b][e] = xb * c + xa * s; }
    }
#pragma unroll
    for (int d0 = 0; d0 < 8; ++d0) { v4u w;
#pragma unroll
      for (int i = 0; i < 4; ++i) w[i] = cvtpk(x[d0][2 * i], x[d0][2 * i + 1]);
      qr[d0] = __builtin_bit_cast(bf16x8, w); }
  }
  f32x16 o[4] = {};
  const int sr = tid >> 4, sc = (tid & 15) * 8, vst0 = v_st(sr, sc), vst1 = v_st(32 + sr, sc);
  const int vb0 = (int)(uintptr_t)V_lds + v_rd_base(lane);
  constexpr int SD = (WIN && WIN_SKIP) ? 1 : 2;
  struct { bf16x8 vs0, vs1, ks0, ks1; } sr_[SD];
#define SLOAD(i, k0) do { sr_[i].vs0 = *reinterpret_cast<const bf16x8*>(&Vh[(long)((k0) + sr) * LDK + sc]); sr_[i].vs1 = *reinterpret_cast<const bf16x8*>(&Vh[(long)((k0) + 32 + sr) * LDK + sc]); \
    sr_[i].ks0 = *reinterpret_cast<const bf16x8*>(&Kh[(long)((k0) + sr) * LDK + sc]); sr_[i].ks1 = *reinterpret_cast<const bf16x8*>(&Kh[(long)((k0) + 32 + sr) * LDK + sc]); } while (0)
#define SWRITE(b, i) do { *(bf16x8*)((char*)V_lds + (b) * SHM_V + vst0) = sr_[i].vs0;          \
    *(bf16x8*)((char*)V_lds + (b) * SHM_V + vst1) = sr_[i].vs1; int kc = sc * 2;               \
    *(bf16x8*)((char*)K_lds + (b) * SHM_K + KSWZ(sr, kc)) = sr_[i].ks0;                       \
    *(bf16x8*)((char*)K_lds + (b) * SHM_K + KSWZ(32 + sr, kc)) = sr_[i].ks1; } while (0)
#define SWAIT() do { if constexpr (SD == 2) asm volatile("s_waitcnt vmcnt(4)" ::: "memory"); else asm volatile("s_waitcnt vmcnt(0)" ::: "memory"); } while (0)
#define RESC(a) do { if (__any((a) < 1.f)) { if (hi == 0) al_l[r32] = (a); asm volatile("s_waitcnt lgkmcnt(0)" ::: "memory"); \
    _Pragma("unroll") for (int d = 0; d < 4; ++d) _Pragma("unroll") for (int r = 0; r < 16; ++r) o[d][r] *= al_l[crow(r, hi)]; } } while (0)
  f32x16 pA0, pA1, pB0, pB1; float mnA, mnB, alA = 1.f, alB = 1.f; bf16x8 pa0, pa1, pa2, pa3; const int NT = seq / KVBLK;
  constexpr int SE = 0, SO = SD - 1;
  SLOAD(SE, 0); asm volatile("s_waitcnt vmcnt(0)" ::: "memory"); SWRITE(0, SE); __syncthreads();
  if (wid >= 4) __builtin_amdgcn_s_setprio(1);
  bool nA = NEED(0), nB = false;
  if (nA) { qkt(pA0, pA1, K_lds, qr, r32, hi); partialSM<WIN>(pA0, pA1, m_reg, mnA, alA, kqw, hi); }
  SLOAD(SO, KVBLK); if constexpr (SD == 2) { if (2 < NT) SLOAD(SE, 2 * KVBLK); }
  SWAIT(); SWRITE(1, SO); __syncthreads();
  for (int j = 1; j + 1 < NT; j += 2) {
    nB = NEED(j);
    SBAR(); if (nB) qkt(pB0, pB1, (bf16*)((char*)K_lds + SHM_K), qr, r32, hi);
    if (nA) finishSM(pA0, pA1, alA, l_reg, pa0, pa1, pa2, pa3); SBAR();
    SLOAD(SO, (j + SD) * KVBLK); SBAR();
    if (nA) pv_d0(o, vb0, pa0, pa1, pa2, pa3);
    alB = 1.f; if (nB) partialSM<WIN>(pB0, pB1, m_reg, mnB, alB, kqw + j * KVBLK, hi);
    __syncthreads(); SWAIT(); SWRITE(0, SE);
    RESC(alB); __syncthreads();
    nA = NEED(j + 1);
    SBAR(); if (nA) qkt(pA0, pA1, K_lds, qr, r32, hi);
    if (nB) finishSM(pB0, pB1, alB, l_reg, pa0, pa1, pa2, pa3); SBAR();
    if (SD == 1 || j + 3 < NT) SLOAD(SE, (j + 1 + SD) * KVBLK); SBAR();
    if (nB) pv_d0(o, vb0 + (int)SHM_V, pa0, pa1, pa2, pa3);
    alA = 1.f; if (nA) partialSM<WIN>(pA0, pA1, m_reg, mnA, alA, kqw + (j + 1) * KVBLK, hi);
    __syncthreads(); SWAIT(); SWRITE(1, SO);
    RESC(alA); __syncthreads();
  }
  nB = NEED(NT - 1);
  SBAR(); if (nB) qkt(pB0, pB1, (bf16*)((char*)K_lds + SHM_K), qr, r32, hi);
  if (nA) finishSM(pA0, pA1, alA, l_reg, pa0, pa1, pa2, pa3); SBAR();
  if (nA) pv_d0(o, vb0, pa0, pa1, pa2, pa3);
  alB = 1.f; if (nB) partialSM<WIN>(pB0, pB1, m_reg, mnB, alB, kqw + (NT - 1) * KVBLK, hi);
  __syncthreads(); RESC(alB);
  if (nB) { finishSM(pB0, pB1, alB, l_reg, pa0, pa1, pa2, pa3); SBAR();
    pv_d0(o, vb0 + (int)SHM_V, pa0, pa1, pa2, pa3); }
  __builtin_amdgcn_s_setprio(0);
  if (hi == 0) li_l[r32] = l_reg; asm volatile("s_waitcnt lgkmcnt(0)" ::: "memory");
  bf16* Ow = Ob + (long)wrow * LDO + wcol;
  const bool odd = (r32 & 1) != 0; float ssq_mine = 0.f;
#pragma unroll
  for (int r = 0; r < 16; ++r) { const int orow = crow(r, hi); const float rl = __builtin_amdgcn_rcpf(li_l[orow]);
    const float v0 = o[0][r] * rl, v1 = o[1][r] * rl, v2 = o[2][r] * rl, v3 = o[3][r] * rl;
    { float q = (v0 * v0 + v1 * v1) + (v2 * v2 + v3 * v3);
      q = dpp_add<0xB1, 0xf>(q); q = dpp_add<0x4E, 0xf>(q); q = dpp_add<0x141, 0xf>(q); q = dpp_add<0x140, 0xf>(q); q = dpp_add<0x142, 0xa>(q);
      if (r32 == 16 + r) ssq_mine = q; }
    const float sa = odd ? v0 : v2, sb = odd ? v1 : v3;
    const float ra = __shfl_xor(sa, 1), rb = __shfl_xor(sb, 1);
    const unsigned wa = odd ? cvtpk(ra, v2) : cvtpk(v0, ra), wb = odd ? cvtpk(rb, v3) : cvtpk(v1, rb);
    unsigned* dst = (unsigned*)(Ow + (long)orow * LDO + (odd ? 64 : 0) + (r32 & ~1));
    dst[0] = wa; dst[16] = wb; }
  if (r32 >= 16) Sp[(long)(wrow + crow(r32 - 16, hi)) * 16 + (WIN ? (wid >> 2) : 0)] = ssq_mine;
  __syncthreads();
#undef SLOAD
#undef SWRITE
#undef SWAIT
#undef RESC
#undef NEED
}
#undef KSWZ
#undef SBAR
}


__device__ __forceinline__ void tr_item(const float* W, int ldw, int k0, int n0, const float* ks, bf16* WT, int ldk, int drow0, LAS float* scr, int lane) {
    f32x4 v[8];
    const int lr = lane >> 3, lc = (lane & 7) * 4;
#pragma unroll
    for (int q = 0; q < 8; ++q) v[q] = __builtin_nontemporal_load((const f32x4*)(W + (size_t)(k0 + q * 8 + lr) * ldw + n0 + lc));
#pragma unroll
    for (int q = 0; q < 8; ++q) { const int kk = q * 8 + lr; const float s = ks ? ks[kk] : 1.f; LAS float* d = scr + kk * 33 + lc; d[0] = v[q].x * s; d[1] = v[q].y * s; d[2] = v[q].z * s; d[3] = v[q].w * s; }
    asm volatile("s_waitcnt lgkmcnt(0)" ::: "memory");
    const int c = lane & 7;
#pragma unroll
    for (int j = 0; j < 4; ++j) { const int n = lr + 8 * j; const LAS float* s = scr + (8 * c) * 33 + n;
        v4u o; o.x = pk2(s[0 * 33], s[1 * 33]); o.y = pk2(s[2 * 33], s[3 * 33]); o.z = pk2(s[4 * 33], s[5 * 33]); o.w = pk2(s[6 * 33], s[7 * 33]);
        *(v4u*)(WT + (size_t)(drow0 + n) * ldk + k0 + 8 * c) = o; }
    asm volatile("s_waitcnt lgkmcnt(0)" ::: "memory");
}
struct Tr8 { f32x4 v[2][8]; };
__device__ __forceinline__ void tr8_load(Tr8& t, const float* W, int ldw, int k0, int n0, int lane) {
    const int lr = lane >> 3, lc = (lane & 7) * 4;
#pragma unroll
    for (int hf = 0; hf < 2; ++hf)
#pragma unroll
        for (int q = 0; q < 8; ++q) t.v[hf][q] = __builtin_nontemporal_load((const f32x4*)(W + (size_t)(k0 + hf * 64 + q * 8 + lr) * ldw + n0 + lc));
}
__device__ __forceinline__ void tr8_finish(const Tr8& t, int k0, float sc, unsigned char* WT, int ldk, int drow0, LAS float* scr, int lane) {
    LAS unsigned* s32 = (LAS unsigned*)scr;
    { const int lr = lane >> 3, lcg = lane & 7;
#pragma unroll
      for (int hf = 0; hf < 2; ++hf)
#pragma unroll
        for (int q = 0; q < 8; ++q) { const int k = hf * 64 + q * 8 + lr; const f32x4 v = t.v[hf][q] * sc;
            unsigned w = 0; w = __builtin_amdgcn_cvt_pk_fp8_f32(v.x, v.y, w, false); w = __builtin_amdgcn_cvt_pk_fp8_f32(v.z, v.w, w, true);
            s32[(k + (k >> 4)) * 8 + lcg] = w; } }
    asm volatile("s_waitcnt lgkmcnt(0)" ::: "memory");
    const int n4 = lane & 7, c = lane >> 3;
    unsigned d[16];
#pragma unroll
    for (int i = 0; i < 16; ++i) d[i] = s32[(16 * c + i + c) * 8 + n4];
    v4u o[4];
#pragma unroll
    for (int q = 0; q < 4; ++q) {
        const unsigned t0 = __builtin_amdgcn_perm(d[4 * q + 1], d[4 * q + 0], 0x05010400u), t1 = __builtin_amdgcn_perm(d[4 * q + 1], d[4 * q + 0], 0x07030602u);
        const unsigned t2 = __builtin_amdgcn_perm(d[4 * q + 3], d[4 * q + 2], 0x05010400u), t3 = __builtin_amdgcn_perm(d[4 * q + 3], d[4 * q + 2], 0x07030602u);
        o[0][q] = __builtin_amdgcn_perm(t2, t0, 0x05040100u); o[1][q] = __builtin_amdgcn_perm(t2, t0, 0x07060302u);
        o[2][q] = __builtin_amdgcn_perm(t3, t1, 0x05040100u); o[3][q] = __builtin_amdgcn_perm(t3, t1, 0x07060302u); }
#pragma unroll
    for (int r = 0; r < 4; ++r) __builtin_nontemporal_store(o[r], (v4u*)(WT + (size_t)(drow0 + n4 * 4 + r) * ldk + k0 + 16 * c));
    asm volatile("s_waitcnt lgkmcnt(0)" ::: "memory");
}
__device__ __forceinline__ void tr_item8(const float* W, int ldw, int k0, int n0, float sc, unsigned char* WT, int ldk, int drow0, LAS float* scr, int lane) {
    Tr8 t; tr8_load(t, W, ldw, k0, n0, lane); asm volatile("" ::: "memory"); tr8_finish(t, k0, sc, WT, ldk, drow0, scr, lane);
}
#ifndef DENSE_DN_FP8
#define DENSE_DN_FP8 1
#endif
#ifndef EXP_IN_ATTN
#define EXP_IN_ATTN 1
#endif
struct ExpIt { const float* W; unsigned char* WT; int ldw, ldk, k0, n0, drow0; };
__device__ __forceinline__ ExpIt exp_desc(const Args& a, int r) {
    ExpIt d; const int m = r / 2816; r %= 2816;
    if (m >= 16) { const int e = m - 16, kb = r / 64, nn = r % 64; d.W = a.in[21] + (size_t)e * FF * DM; d.ldw = DM; d.k0 = kb * 128; d.n0 = nn * 32; d.WT = a.ws + WS_EDN + (size_t)e * EDN_STRIDE; d.ldk = FF; d.drow0 = nn * 32; }
    else { const bool up = m >= 8; const int e = m & 7, kb = r / 176, nn = r % 176, n0 = nn * 32; d.W = (up ? a.in[20] : a.in[19]) + (size_t)e * DM * FF; d.ldw = FF; d.k0 = kb * 128; d.n0 = n0;
        d.WT = a.ws + WS_EGU + (size_t)e * EGU_STRIDE; d.ldk = DM; d.drow0 = (n0 >> 7) * 256 + (n0 & 127) + (up ? 128 : 0); }
    return d;
}
__device__ __forceinline__ void exp_item(const Args& a, int r, LAS float* scr, int lane) { const ExpIt d = exp_desc(a, r); tr_item8(d.W, d.ldw, d.k0, d.n0, W8_SCALE, d.WT, d.ldk, d.drow0, scr, lane); }
#ifndef INPROJ1_FP8
#define INPROJ1_FP8 1
#endif
constexpr int TR_IN0 = 32 * 96, TR_IN = TR_IN0 + (INPROJ1_FP8 ? 16 * 96 : 32 * 96), TR_OUT = 2 * 32 * 64, TR_F = 5632, TR_F8 = 2816, TR_DENSE = 2 * TR_F + (DENSE_DN_FP8 ? TR_F8 : TR_F), TR_ITEMS = TR_IN + TR_OUT + TR_DENSE + (EXP_IN_ATTN ? 0 : 24 * TR_F8);
__device__ __forceinline__ void ph_weights(const Args& a, LAS unsigned char* lds, int bid, int nb, int tid) {
    const int wave = tid >> 6, lane = tid & 63;
    LAS float* scr = (LAS float*)(lds + wave * 16896);
    for (int it = bid * NWAVES + wave; it < TR_ITEMS; it += nb * NWAVES) {
        int r = it;
        if (r < TR_IN) { const int l = r < TR_IN0 ? 0 : 1; if (l) r -= TR_IN0; const int kb = r / 96, nn = r % 96;
            if (INPROJ1_FP8 && l == 1) tr_item8(a.in[8] + (size_t)DM * NQKV, NQKV, kb * 128, nn * 32, W8_SCALE, a.ws + WS_WIN + WIN_STRIDE, DM, nn * 32, scr, lane);
            else tr_item(a.in[8] + (size_t)l * DM * NQKV, NQKV, kb * 64, nn * 32, nullptr, (bf16*)(a.ws + WS_WIN + l * WIN_STRIDE), DM, nn * 32, scr, lane);
            continue; }
        r -= TR_IN;
        if (r < TR_OUT) { const int l = r / 2048; r %= 2048; const int kb = r / 64, nn = r % 64, k0 = kb * 64;
            const float* ks = k0 < 1024 ? a.in[12] + l * 1024 + k0 : a.in[13] + l * 1024 + (k0 - 1024);
            tr_item(a.in[14] + (size_t)l * DM * DM, DM, k0, nn * 32, ks, (bf16*)(a.ws + WS_WOUT + l * WOUT_STRIDE), DM, nn * 32, scr, lane); continue; }
        r -= TR_OUT;
        if (r < TR_DENSE) {
            const int m = r < 2 * TR_F ? r / TR_F : 2; r -= m * TR_F;
            if (m == 2) { if (DENSE_DN_FP8) { const int kb = r / 64, nn = r % 64; tr_item8(a.in[17], DM, kb * 128, nn * 32, W8_SCALE, a.ws + WS_WDN, FF, nn * 32, scr, lane); }
                          else { const int kb = r / 64, nn = r % 64; tr_item(a.in[17], DM, kb * 64, nn * 32, nullptr, (bf16*)(a.ws + WS_WDN), FF, nn * 32, scr, lane); } }
            else { const int kb = r / 176, nn = r % 176, n0 = nn * 32;
                tr_item(m == 0 ? a.in[15] : a.in[16], FF, kb * 64, n0, nullptr, (bf16*)(a.ws + WS_WGU), DM, (n0 >> 7) * 256 + (n0 & 127) + (m == 1 ? 128 : 0), scr, lane); }
            continue; }
        r -= TR_DENSE;
        if (!EXP_IN_ATTN) exp_item(a, r, scr, lane);
    }
}
__device__ __forceinline__ void ph_expert_burst(const Args& a, LAS unsigned char* lds, int bid, int nb) {
    const int tid = fresh_tid(), wave = __builtin_amdgcn_readfirstlane(tid >> 6), lane = tid & 63;
    LAS float* scr = (LAS float*)(lds + wave * 16896);
    const int st = nb * NWAVES, NIT = 24 * TR_F8;
    for (int it = bid * NWAVES + wave; it < NIT; it += 3 * st) {
        const int i1 = it + st < NIT ? it + st : it, i2 = it + 2 * st < NIT ? it + 2 * st : it;
        const ExpIt d0 = exp_desc(a, it), d1 = exp_desc(a, i1), d2 = exp_desc(a, i2);
        Tr8 A, B, C;
        tr8_load(A, d0.W, d0.ldw, d0.k0, d0.n0, lane); tr8_load(B, d1.W, d1.ldw, d1.k0, d1.n0, lane); tr8_load(C, d2.W, d2.ldw, d2.k0, d2.n0, lane);
        asm volatile("" ::: "memory");
        tr8_finish(A, d0.k0, W8_SCALE, d0.WT, d0.ldk, d0.drow0, scr, lane);
        if (it + st < NIT) tr8_finish(B, d1.k0, W8_SCALE, d1.WT, d1.ldk, d1.drow0, scr, lane);
        if (it + 2 * st < NIT) tr8_finish(C, d2.k0, W8_SCALE, d2.WT, d2.ldk, d2.drow0, scr, lane);
    }
    asm volatile("s_waitcnt vmcnt(0)" ::: "memory");
    __syncthreads();
}

__device__ __forceinline__ void ph_attn(const Args& a, int l, char* lds, int bid, int nb) {
    const bf16* qkv = (const bf16*)(a.ws + WS_QKV); bf16* attb = (bf16*)(a.ws + WS_ATT);
    const float* ropeT = (const float*)(a.ws + WS_ROPE);
    float* ssq = (float*)(a.ws + WS_SSQ);
    const int n_before = (EXP_IN_ATTN && l == 0) ? ((bid >> 3) & 3) : 0;
    int U = bid;
    for (int i = 0; i < n_before && U < 1024; ++i, U += nb) {
        const int x = U & 7, j = (U >> 3) & 31, g = (U >> 8) * 8 + x, b = g >> 1, kvh = g & 1, hq = kvh * 4 + (j >> 3), q0 = (j & 7) * 256;
        const size_t tok0 = (size_t)b * SEQ;
        att::attn_unit<false>(qkv + (tok0 + q0) * NQKV + QA_OFF + hq * HD, qkv + tok0 * NQKV + KA_OFF + kvh * HD, qkv + tok0 * NQKV + VA_OFF + kvh * HD,
                              attb + (tok0 + q0) * DM + hq * HD, SEQ, 0, nullptr, a.in[9] + l * HD, ropeT, ropeT + 2048 * 64, q0, ssq + (tok0 + q0) * 16 + hq, lds);
    }
    if (EXP_IN_ATTN && l == 0) ph_expert_burst(a, (LAS unsigned char*)lds, bid, nb);
    for (; U < 1024; U += nb) {
        const int x = U & 7, j = (U >> 3) & 31, g = (U >> 8) * 8 + x, b = g >> 1, kvh = g & 1, hq = kvh * 4 + (j >> 3), q0 = (j & 7) * 256;
        const size_t tok0 = (size_t)b * SEQ;
        att::attn_unit<false>(qkv + (tok0 + q0) * NQKV + QA_OFF + hq * HD, qkv + tok0 * NQKV + KA_OFF + kvh * HD, qkv + tok0 * NQKV + VA_OFF + kvh * HD,
                              attb + (tok0 + q0) * DM + hq * HD, SEQ, 0, nullptr, a.in[9] + l * HD, ropeT, ropeT + 2048 * 64, q0, ssq + (tok0 + q0) * 16 + hq, lds);
    }
    for (int U = bid; U < 1024; U += nb) {
        const int x = U & 7, j = (U >> 3) & 31, g = (U >> 8) * 8 + x, b = g >> 1, kvh = g & 1, q0 = (j >> 1) * 128, h0 = kvh * 4 + (j & 1) * 2;
        const size_t tok0 = (size_t)b * SEQ;
        const int klo = q0 - 128 < 0 ? 0 : q0 - 128, khi = q0 + 256 > SEQ ? SEQ : q0 + 256;
        att::attn_unit<true>(qkv + (tok0 + q0) * NQKV + QB_OFF + h0 * HD, qkv + (tok0 + klo) * NQKV + KB_OFF + kvh * HD, qkv + (tok0 + klo) * NQKV + VB_OFF + kvh * HD,
                             attb + (tok0 + q0) * DM + 1024 + h0 * HD, khi - klo, klo - q0, a.in[11] + l * 8 + h0, nullptr, ropeT + 2 * 2048 * 64, ropeT + 3 * 2048 * 64, q0, ssq + (tok0 + q0) * 16 + 8 + h0, lds);
    }
}


#define XB_TMO      128
#define XB_XCNT(j)  (256  + 64 * (j))
#define XB_XSUB(j)  (1280 + 64 * (j))
#define XB_XGEN(j)  (2304 + 64 * (j))
#define XB_TOP      3328
#define XB_TOPGEN   3392
#define XCD_BAR_WORDS 3456
#define XB_SPIN_CAP (1u << 18)
__device__ __forceinline__ unsigned xb_ld(unsigned* p)              { return __hip_atomic_load(p, __ATOMIC_RELAXED, __HIP_MEMORY_SCOPE_AGENT); }
__device__ __forceinline__ unsigned xb_add(unsigned* p, unsigned v) { return __hip_atomic_fetch_add(p, v, __ATOMIC_RELAXED, __HIP_MEMORY_SCOPE_AGENT); }
__device__ __forceinline__ unsigned xb_xcc_id() { return (unsigned)__builtin_amdgcn_s_getreg((3 << 11) | 20) & 0xFu; }
#define XB_SPIN(cond, bar) do { unsigned _sp = 0; while (cond) { __builtin_amdgcn_s_sleep(1); \
    if ((++_sp & 255u) == 0u) { if (xb_ld(&(bar)[XB_TMO])) break; if (_sp > XB_SPIN_CAP) { atomicAdd(&(bar)[XB_TMO], 1u); break; } } } } while (0)
struct XcdBarrier { unsigned* bar; unsigned x; volatile LAS unsigned* st; };
__device__ __forceinline__ XcdBarrier xcd_barrier_post(unsigned* bar, volatile LAS unsigned* st) {
    XcdBarrier b; b.bar = bar; b.x = xb_xcc_id(); b.st = st;
    if (threadIdx.x == 0) (void)xb_add(&bar[XB_XCNT(b.x)], 1u);
    return b;
}
__device__ __forceinline__ void xcd_barrier_complete(unsigned* bar, unsigned x, unsigned& nloc, unsigned& nx) {
    const unsigned G = gridDim.x * gridDim.y * gridDim.z;
    unsigned sum, cnt, mine, sp = 0u;
    for (;;) {
        sum = 0u; cnt = 0u; mine = 0u;
#pragma unroll
        for (unsigned j = 0; j < 16; ++j) { const unsigned c = xb_ld(&bar[XB_XCNT(j)]); sum += c; cnt += (c > 0u) ? 1u : 0u; mine = (j == x) ? c : mine; }
        if (sum == G) break;
        __builtin_amdgcn_s_sleep(1);
        if ((++sp & 255u) == 0u) { if (xb_ld(&bar[XB_TMO])) break; if (sp > XB_SPIN_CAP) { atomicAdd(&bar[XB_TMO], 1u); break; } }
    }
    nloc = mine > 0u ? mine : 1u; nx = cnt > 0u ? cnt : 1u;
}
__device__ __forceinline__ void xcd_barrier(const XcdBarrier& b) {
    asm volatile("s_waitcnt vmcnt(0)" ::: "memory");
    __syncthreads();
    if (threadIdx.x == 0) {
        unsigned* bar = b.bar;
        __builtin_amdgcn_s_waitcnt(0);
        unsigned nloc = b.st[0], nx = b.st[1];
        if (nloc == 0u) { xcd_barrier_complete(bar, b.x, nloc, nx); b.st[0] = nloc; b.st[1] = nx; }
        const unsigned old = xb_add(&bar[XB_XSUB(b.x)], 1u);
        const unsigned gen = old / nloc;
        if (old + 1u == (gen + 1u) * nloc) {
            __builtin_amdgcn_fence(__ATOMIC_RELEASE, "agent");
            asm volatile("s_waitcnt vmcnt(0)" ::: "memory");
            const unsigned og = xb_add(&bar[XB_TOP], 1u);
            const unsigned tg = og / nx;
            if (og + 1u == (tg + 1u) * nx) xb_add(&bar[XB_TOPGEN], 1u);
            else XB_SPIN(xb_ld(&bar[XB_TOPGEN]) == tg, bar);
            __builtin_amdgcn_fence(__ATOMIC_ACQUIRE, "agent");
            xb_add(&bar[XB_XGEN(b.x)], 1u);
            asm volatile("s_waitcnt vmcnt(0)" ::: "memory");
        } else {
            XB_SPIN(xb_ld(&bar[XB_XGEN(b.x)]) == gen, bar);
            __builtin_amdgcn_fence(__ATOMIC_ACQUIRE, "agent");
            asm volatile("s_waitcnt vmcnt(0)" ::: "memory");
        }
    }
    __syncthreads();
}
constexpr int CW_BAR = 4096;
constexpr int LDS_XB = LDS_BYTES - 16;

#ifndef WGM_IN
#define WGM_IN 4
#endif
#ifndef WGM_OUT
#define WGM_OUT 4
#endif
#ifndef WGM_GU
#define WGM_GU 4
#endif
#ifndef WGM_DN
#define WGM_DN 4
#endif
#ifndef WGM_EGU
#define WGM_EGU 4
#endif
#ifndef WGM_EDN
#define WGM_EDN 4
#endif
__global__ void __launch_bounds__(NTHR, 2) mega(Args a) {
    extern __shared__ __attribute__((aligned(16))) unsigned char lds_raw[];
    LAS unsigned char* lds = (LAS unsigned char*)lds_raw;
    const int bid = blockIdx.x, nb = gridDim.x;
    const int lo = a.ph_lo, hi = a.ph_hi;
#define PH_TID const int tid = fresh_tid(), wave = __builtin_amdgcn_readfirstlane(tid >> 6), lane = tid & 63; (void)wave; (void)lane
#define IN(k) (lo <= (k) && (k) < hi)
#define REPS(id) ((PROBE_DUP == (id)) ? 2 : 1)
#define SEAM(k) do { if (IN(k) && IN((k) + 1)) xcd_barrier(bar); } while (0)
    if (threadIdx.x < 4) ((LAS unsigned*)(lds + LDS_XB))[threadIdx.x] = 0u;
    __syncthreads();
    XcdBarrier bar; bar.bar = (unsigned*)(a.ws + WS_CTL) + CW_BAR; bar.x = 0; bar.st = nullptr;
    if (hi - lo > 1) bar = xcd_barrier_post((unsigned*)(a.ws + WS_CTL) + CW_BAR, (volatile LAS unsigned*)(lds + LDS_XB));
    const float* modv = (const float*)(a.ws + WS_MODV);
    bf16* hbuf = (bf16*)(a.ws + WS_H);
    if (IN(0)) for (int rep = 0; rep < REPS(1); ++rep) { PH_TID; ph_mod(a, lds, bid, nb, tid); ph_tables(a, bid, nb, tid); ph_weights(a, lds, bid, nb, tid); __syncthreads(); }
    SEAM(0);
    if (IN(1)) for (int rep = 0; rep < REPS(6); ++rep) { PH_TID;
        constexpr int HIN = 1;
#define LD0(R, t) do { const float* mv = modv + (size_t)(0 * 16 + ((t) >> 11)) * NMOD; row_load<0, HIN, false>(R, t, lane, a.in[0], nullptr, nullptr, nullptr, nullptr, mv + 1 * DM, mv + 0 * DM); } while (0)
#define FN0(R, t) row_finish<0, HIN, false, false>(R, t, lane, nullptr, hbuf, nullptr, nullptr, nullptr)
        ROW_LOOP(0, HIN, LD0, FN0);
#undef LD0
#undef FN0
    }
    SEAM(1);
    if (PROBE_DUP == 8) for (int rep = 0; rep < 20; ++rep) xcd_barrier(bar);
    if (IN(2)) for (int rep = 0; rep < REPS(2); ++rep) { pg8::StaticOrder S; S.init(T / 256, NQKV / 256, nb, bid, WGM_IN); pg8::EpiPlain E{(bf16*)(a.ws + WS_QKV), NQKV, 1.0f};
        pg8::gemm_phase<pg8::EpiPlain, false, false>(lds, (const char*)hbuf, nullptr, (const char*)(a.ws + WS_WIN), nullptr, 0, DM, S, E); }
    SEAM(2);
    for (int l = 0; l < DEPTH; ++l) {
        const int base = 2 + 11 * l; const bool moe = (l & 1) != 0;
        if (IN(base + 1)) { PH_TID; ph_prep(a, l, bid, nb, tid); }
        SEAM(base + 1);
        if (IN(base + 2)) for (int rep = 0; rep < REPS(3); ++rep) ph_attn(a, l, (char*)lds_raw, bid, nb);
        SEAM(base + 2);
        if (IN(base + 3)) for (int rep = 0; rep < REPS(11); ++rep) { PH_TID; ph_attn_norm(a, bid, nb, tid); }
        SEAM(base + 3);
        if (IN(base + 4)) for (int rep = 0; rep < REPS(9); ++rep) { pg8::StaticOrder S; S.init(T / 256, DM / 256, nb, bid, WGM_OUT); pg8::EpiRowScale E{(bf16*)(a.ws + WS_Y), DM, (const float*)(a.ws + WS_FAC)};
            pg8::gemm_phase<pg8::EpiRowScale, false, false>(lds, (const char*)(a.ws + WS_ATT), nullptr, (const char*)(a.ws + WS_WOUT + l * WOUT_STRIDE), nullptr, 0, DM, S, E); }
        SEAM(base + 4);
        if (IN(base + 5)) for (int rep = 0; rep < (l == 0 ? REPS(7) : 1); ++rep) { PH_TID;
            const bf16* y = (const bf16*)(a.ws + WS_Y); float* xb = (float*)(a.ws + WS_XB);
            if (moe) {
                LAS float* wrT = (LAS float*)lds;
                const float* wr = a.in[18] + (size_t)(l >> 1) * DM * NE;
                for (int i = tid; i < DM * NE; i += NTHR) { const int d = i >> 3, e = i & 7; wrT[e * DM + d] = wr[i]; }
                __syncthreads();
#define LD5M(R, t) do { const float* mv = modv + (size_t)(l * 16 + ((t) >> 11)) * NMOD; row_load<1, 2, true>(R, t, lane, xb, y, nullptr, nullptr, mv + 2 * DM, mv + 4 * DM, mv + 3 * DM); } while (0)
#define FN5M(R, t) row_finish<1, 2, true, true>(R, t, lane, xb, (bf16*)(a.ws + WS_H8), wrT, (int*)(a.ws + WS_TOPI), (float*)(a.ws + WS_TOPW))
                ROW_LOOP(1, 2, LD5M, FN5M);
                __syncthreads();
            } else {
#define LD5D(R, t) do { const float* mv = modv + (size_t)(l * 16 + ((t) >> 11)) * NMOD; row_load<1, 1, false>(R, t, lane, a.in[0], y, nullptr, nullptr, mv + 2 * DM, mv + 4 * DM, mv + 3 * DM); } while (0)
#define FN5D(R, t) row_finish<1, 1, false, true>(R, t, lane, xb, hbuf, nullptr, nullptr, nullptr)
                ROW_LOOP(1, 1, LD5D, FN5D);
            }
#undef LD5M
#undef FN5M
#undef LD5D
#undef FN5D
        }
        SEAM(base + 5);
        if (IN(base + 6) && moe) for (int rep = 0; rep < REPS(14); ++rep) { PH_TID; ph_route_cnt(a, lds, bid, nb, tid); }
        if (moe) SEAM(base + 6);
        if (IN(base + 7) && moe) for (int rep = 0; rep < REPS(14); ++rep) { PH_TID; ph_route_build(a, lds, bid, nb, tid); }
        if (moe) SEAM(base + 7);
        if (IN(base + 8)) for (int rep = 0; rep < (moe ? REPS(5) : REPS(4)); ++rep) {
            if (!moe) { pg8::StaticOrder S; S.init(T / 256, 2 * FF / 256, nb, bid, WGM_GU);
#if DENSE_DN_FP8
                pg8::EpiSwiglu8 E{(unsigned char*)(a.ws + WS_ACT), FF, 1.0f};
                pg8::gemm_phase<pg8::EpiSwiglu8, false, false>(lds, (const char*)hbuf, nullptr, (const char*)(a.ws + WS_WGU), nullptr, 0, DM, S, E); }
#else
                pg8::EpiSwiglu E{(bf16*)(a.ws + WS_ACT), FF};
                pg8::gemm_phase<pg8::EpiSwiglu, false, false>(lds, (const char*)hbuf, nullptr, (const char*)(a.ws + WS_WGU), nullptr, 0, DM, S, E); }
#endif
            else { const int* tile = (const int*)(a.ws + WS_TILE); const int ntile = __builtin_amdgcn_readfirstlane(tile[512]);
                pg8::StaticOrder S; S.init(ntile, 2 * FF / 256, nb, bid, WGM_EGU); pg8::EpiSwiglu8 E{(unsigned char*)(a.ws + WS_ACTM), FF, W8_INV};
                pg8::gemm_phase<pg8::EpiSwiglu8, true, true, true>(lds, (const char*)(a.ws + WS_H8), (const int*)(a.ws + WS_ROWL), (const char*)(a.ws + WS_EGU), tile, EGU_STRIDE, DM, S, E); }
        }
        SEAM(base + 8);
        if (IN(base + 9)) for (int rep = 0; rep < (moe ? REPS(5) : REPS(4)); ++rep) {
            if (!moe) { pg8::StaticOrder S; S.init(T / 256, DM / 256, nb, bid, WGM_DN); pg8::EpiPlain E{(bf16*)(a.ws + WS_Y2), DM, DENSE_DN_FP8 ? W8_INV : 1.0f};
                pg8::gemm_phase<pg8::EpiPlain, false, false, DENSE_DN_FP8 != 0>(lds, (const char*)(a.ws + WS_ACT), nullptr, (const char*)(a.ws + WS_WDN), nullptr, 0, FF, S, E); }
            else { const int* tile = (const int*)(a.ws + WS_TILE); const int ntile = __builtin_amdgcn_readfirstlane(tile[512]);
                const int nmain = (ntile * (DM / 256) / nb) * nb / (DM / 256);
                pg8::StaticOrder S; S.init(nmain, DM / 256, nb, bid, WGM_EDN); pg8::EpiPlain E{(bf16*)(a.ws + WS_YS), DM, W8_INV};
                pg8::gemm_phase<pg8::EpiPlain, false, true, true>(lds, (const char*)(a.ws + WS_ACTM), nullptr, (const char*)(a.ws + WS_EDN), tile, EDN_STRIDE, FF, S, E); }
        }
        SEAM(base + 9);
        if (IN(base + 10)) { PH_TID;
            static_assert(DEPTH == 2, "row_end variants: layer 0 = dense FFN + next layer's h, layer 1 = MoE combine, last");
            constexpr int HN = INPROJ1_FP8 ? 2 : 1;
            float* xb = (float*)(a.ws + WS_XB);
#define LD10D(R, t) do { const float* mv = modv + (size_t)(l * 16 + ((t) >> 11)) * NMOD; const float* mn = modv + (size_t)((l + 1) * 16 + ((t) >> 11)) * NMOD; \
                row_load<1, HN, true>(R, t, lane, xb, (const bf16*)(a.ws + WS_Y2), nullptr, nullptr, mv + 5 * DM, mn + 1 * DM, mn + 0 * DM); } while (0)
#define FN10D(R, t) row_finish<1, HN, false, true>(R, t, lane, xb, INPROJ1_FP8 ? (bf16*)(a.ws + WS_H8) : hbuf, nullptr, nullptr, nullptr)
#define LD10M(R, t) do { const float* mv = modv + (size_t)(l * 16 + ((t) >> 11)) * NMOD; \
                row_load<2, 0, true>(R, t, lane, xb, (const bf16*)(a.ws + WS_YS), (const int*)(a.ws + WS_SLOT), (const float*)(a.ws + WS_TOPW), mv + 5 * DM, nullptr, nullptr); } while (0)
#define FN10M(R, t) row_finish<2, 0, false, false>(R, t, lane, a.out, nullptr, nullptr, nullptr, nullptr)
            if (moe) { const int* slot_of = (const int*)(a.ws + WS_SLOT); const float* topw = (const float*)(a.ws + WS_TOPW);
                const int* tile = (const int*)(a.ws + WS_TILE); const int ntile = __builtin_amdgcn_readfirstlane(tile[512]);
                const int nmain = (ntile * (DM / 256) / nb) * nb / (DM / 256), ntail = ntile - nmain, R = ntail * (DM / 256);
                const float* gv = modv + (size_t)(l * 16) * NMOD + 5 * DM;
                const int rowsB = (R * NWAVES * 8 < T / 2) ? R * NWAVES * 8 : T / 2;
                auto combine = [&](int t, const int tend, const int st) { Slots cur{0, 0, 0.f, 0.f};
                    if (t < tend) { cur.s0 = slot_of[2 * t]; cur.s1 = slot_of[2 * t + 1]; cur.w0 = topw[2 * t]; cur.w1 = topw[2 * t + 1]; }
                    for (; t < tend; t += st) { RowIn<2, 0> R_; Slots nxt; const int tn = t + st < tend ? t + st : t;
                        row_load_moe(R_, t, tn, lane, (const bf16*)xb, (const bf16*)(a.ws + WS_YS), slot_of, topw, cur, nxt, gv + (size_t)(t >> 11) * NMOD);
                        FN10M(R_, t); cur = nxt; } };
                if (bid < R) { { pg8::StaticOrder S; S.init(ntail, DM / 256, R, bid, WGM_EDN); pg8::EpiPlain E{(bf16*)(a.ws + WS_YS) + (size_t)nmain * 256 * DM, DM, W8_INV};
                    pg8::gemm_phase<pg8::EpiPlain, false, true, true>(lds, (const char*)(a.ws + WS_ACTM) + (size_t)nmain * 256 * FF, nullptr, (const char*)(a.ws + WS_EDN), tile + nmain, EDN_STRIDE, FF, S, E); }
                    combine(T - rowsB + bid * NWAVES + wave, T, R * NWAVES); }
                else combine((bid - R) * NWAVES + wave, T - rowsB, (nb - R) * NWAVES);
                if (R > 0) { xcd_barrier(bar);
                    const int* rowl = (const int*)(a.ws + WS_ROWL);
                    for (int sl = nmain * 256 + bid * NWAVES + wave; sl < ntile * 256; sl += nb * NWAVES) { const int t = rowl[sl]; RowIn<2, 0> R_; Slots cur, nxt;
                        cur.s0 = slot_of[2 * t]; cur.s1 = slot_of[2 * t + 1]; cur.w0 = topw[2 * t]; cur.w1 = topw[2 * t + 1];
                        row_load_moe(R_, t, t, lane, (const bf16*)xb, (const bf16*)(a.ws + WS_YS), slot_of, topw, cur, nxt, gv + (size_t)(t >> 11) * NMOD);
                        FN10M(R_, t); } } }
            else ROW_LOOP(1, HN, LD10D, FN10D);
#undef LD10D
#undef FN10D
#undef LD10M
#undef FN10M
        }
        SEAM(base + 10);
        if (l + 1 < DEPTH) {
            if (IN(base + 11)) for (int rep = 0; rep < REPS(2); ++rep) { pg8::StaticOrder S; S.init(T / 256, NQKV / 256, nb, bid, WGM_IN);
#if INPROJ1_FP8
                pg8::EpiPlain E{(bf16*)(a.ws + WS_QKV), NQKV, W8_INV};
                pg8::gemm_phase<pg8::EpiPlain, false, false, true>(lds, (const char*)(a.ws + WS_H8), nullptr, (const char*)(a.ws + WS_WIN + (l + 1) * WIN_STRIDE), nullptr, 0, DM, S, E); }
#else
                pg8::EpiPlain E{(bf16*)(a.ws + WS_QKV), NQKV, 1.0f};
                pg8::gemm_phase<pg8::EpiPlain, false, false>(lds, (const char*)hbuf, nullptr, (const char*)(a.ws + WS_WIN + (l + 1) * WIN_STRIDE), nullptr, 0, DM, S, E); }
#endif
            SEAM(base + 11);
        }
    }
#undef IN
#undef SEAM
#undef PH_TID
}

extern "C" void kernel_launch(void* const* d_in, const int* in_sizes, int n_in, void* d_out, int out_size, void* d_ws, size_t ws_size, hipStream_t stream) {
    static int grid = 0;
    if (grid == 0) {
        if (n_in != 22 || in_sizes[0] != T * DM || out_size != T * DM || ws_size < WS_END) {
            fprintf(stderr, "kernel_launch: unexpected shapes: n_in %d in0 %d out %d ws %zu (need %zu); nothing launched\n", n_in, n_in > 0 ? in_sizes[0] : -1, out_size, ws_size, (size_t)WS_END);
            grid = -1; return; }
        int dev = 0, cus = 0;
        if (hipGetDevice(&dev) != hipSuccess || hipDeviceGetAttribute(&cus, hipDeviceAttributeMultiprocessorCount, dev) != hipSuccess) { grid = -1; return; }
        if (hipFuncSetAttribute((const void*)mega, hipFuncAttributeMaxDynamicSharedMemorySize, LDS_BYTES) != hipSuccess) { fprintf(stderr, "kernel_launch: hipFuncSetAttribute failed\n"); grid = -1; return; }
        int per_cu = 0;
        if (hipOccupancyMaxActiveBlocksPerMultiprocessor(&per_cu, (const void*)mega, NTHR, LDS_BYTES) != hipSuccess || per_cu < 1)
            fprintf(stderr, "kernel_launch: note: the occupancy query reports %d workgroups per CU\n", per_cu);
        (void)hipGetLastError();
        grid = cus;
    }
    if (grid < 0) return;
    (void)hipMemsetAsync((char*)d_ws + WS_CTL, 0, CTL_ZERO_BYTES, stream);
    Args a{};
    for (int i = 0; i < 22; ++i) a.in[i] = (const float*)d_in[i];
    a.out = (float*)d_out; a.ws = (unsigned char*)d_ws;
    a.ph_lo = 0; a.ph_hi = 2 + 11 * DEPTH;
    hipLaunchKernelGGL(mega, dim3(grid), dim3(NTHR), LDS_BYTES, stream, a);
}
```

```cpp
#include <hip/hip_runtime.h>
#include <cstdio>
#include <cstdint>

#define GAS __attribute__((address_space(1)))
#define LAS __attribute__((address_space(3)))
typedef unsigned short bf16;
typedef unsigned v4u __attribute__((ext_vector_type(4)));
typedef unsigned v2u __attribute__((ext_vector_type(2)));
typedef float f32x4 __attribute__((ext_vector_type(4)));
typedef float f32x2 __attribute__((ext_vector_type(2)));
typedef float f32x16 __attribute__((ext_vector_type(16)));
typedef short bf16x8 __attribute__((ext_vector_type(8)));

#ifndef PROBE_DUP
#define PROBE_DUP 0
#endif
constexpr int BATCH = 16, SEQ = 2048, DM = 2048, T = BATCH * SEQ, NQKV = 3072, FF = 5632, NE = 8, HD = 128, DEPTH = 2, NMOD = 6 * DM;
constexpr int QA_OFF = 0, KA_OFF = 1024, VA_OFF = 1280, QB_OFF = 1536, KB_OFF = 2560, VB_OFF = 2816;
constexpr float EPS = 1e-6f;
constexpr int NSLOT = 2 * T + NE * 256;
constexpr int NWAVES = 8, NTHR = NWAVES * 64;

constexpr size_t MiB = 1u << 20;
constexpr size_t WS_CTL = 0, CTL_ZERO_BYTES = 1 * MiB;
constexpr size_t WS_MODV = 1 * MiB;
constexpr size_t WS_ROPE = 3 * MiB;
constexpr size_t WS_TOPI = 5 * MiB;
constexpr size_t WS_TOPW = WS_TOPI + 256 * 1024;
constexpr size_t WS_SLOT = WS_TOPW + 256 * 1024;
constexpr size_t WS_ROWL = 6 * MiB;
constexpr size_t WS_CNT  = 6 * MiB + 512 * 1024;
constexpr size_t WS_TILE = WS_CNT + 16 * 1024;
constexpr size_t WS_GCAT = 7 * MiB;
constexpr size_t WS_WEXP = 8 * MiB;
constexpr size_t WS_H    = 536 * MiB;
constexpr size_t WS_D    = 664 * MiB;
constexpr size_t WS_QKV  = WS_D, WS_ATT = WS_D + 192 * MiB, WS_Y = WS_D + 320 * MiB;
constexpr size_t WS_ACT  = WS_D, WS_Y2 = WS_D + 352 * MiB;
constexpr size_t WS_ACTM = WS_D, WS_YS = WS_D + 726 * MiB;
constexpr size_t WS_END  = WS_D + 990 * MiB;
constexpr size_t WS_EGU = WS_WEXP, EGU_STRIDE = 22 * MiB, WS_EDN = WS_WEXP + 176 * MiB, EDN_STRIDE = 11 * MiB;
constexpr size_t WS_H8 = WS_WEXP + 264 * MiB;
constexpr size_t WS_SSQ = 336 * MiB, WS_FAC = 338 * MiB;
constexpr size_t WS_XB = 340 * MiB;
constexpr size_t WS_LW = WS_D + 884 * MiB, WS_WIN = WS_LW, WIN_STRIDE = 12 * MiB, WS_WOUT = WS_LW + 24 * MiB, WOUT_STRIDE = 8 * MiB, WS_WGU = WS_LW + 40 * MiB, WS_WDN = WS_LW + 84 * MiB;
static_assert(WS_H8 + 64 * MiB <= WS_XB && WS_XB + 128 * MiB <= WS_H, "residual buffer");
static_assert(WS_EDN + 8 * EDN_STRIDE <= WS_H8 && WS_H8 + 64 * MiB <= WS_H && WS_WDN + 22 * MiB <= WS_END && WS_LW >= WS_YS, "weight copies");
constexpr float W8_SCALE = 256.0f, W8_INV = 1.0f / 256.0f;
static_assert((size_t)NSLOT * FF * 2 <= 726 * MiB && (size_t)NSLOT * DM * 2 <= 264 * MiB, "moe scratch");

constexpr int LDS_BYTES = 147456;

template <int CTRL, int RM> __device__ __forceinline__ float dpp_add(float v) { return v + __builtin_bit_cast(float, __builtin_amdgcn_update_dpp(0, __builtin_bit_cast(int, v), CTRL, RM, 0xf, false)); }
__device__ __forceinline__ float wave_sum(float v) {
    v = dpp_add<0xB1, 0xf>(v); v = dpp_add<0x4E, 0xf>(v); v = dpp_add<0x141, 0xf>(v); v = dpp_add<0x140, 0xf>(v);
    v = dpp_add<0x142, 0xa>(v); v = dpp_add<0x143, 0xc>(v);
    return __builtin_bit_cast(float, __builtin_amdgcn_readlane(__builtin_bit_cast(int, v), 63));
}
__device__ __forceinline__ unsigned f2bf(float f) { unsigned u = __builtin_bit_cast(unsigned, f); return (u + 0x7fffu + ((u >> 16) & 1u)) >> 16; }
__device__ __forceinline__ unsigned pk2(float lo, float hi) { return f2bf(lo) | (f2bf(hi) << 16); }
__device__ __forceinline__ float bflo(unsigned w) { return __builtin_bit_cast(float, w << 16); }
__device__ __forceinline__ float bfhi(unsigned w) { return __builtin_bit_cast(float, w & 0xffff0000u); }

__device__ __forceinline__ int fresh_tid() { int t = threadIdx.x; asm volatile("" : "+v"(t)); return t; }
struct Args { const float* in[22]; float* out; unsigned char* ws; int ph_lo, ph_hi, layer, pad; };

__device__ __forceinline__ void ph_mod(const Args& a, LAS unsigned char* lds, int bid, int nb, int tid) {
    LAS float* cT = (LAS float*)lds;
    LAS float* red = (LAS float*)lds;
    const float* c = a.in[1];
    float* modv = (float*)(a.ws + WS_MODV);
    const int wave = tid >> 6, lane = tid & 63, cl = lane & 31, kp = lane >> 5;
    for (int u = bid; u < 768; u += nb) {
        for (int i = tid; i < 16 * 2048; i += NTHR) { const int b = i >> 11, k = i & 2047; const float v = c[i]; cT[k * 16 + b] = v / (1.f + __expf(-v)); }
        __syncthreads();
        const int l = u / 384, n0 = (u % 384) * 32;
        const float* W = a.in[2] + (size_t)l * DM * NMOD + n0 + cl;
        float acc[16];
#pragma unroll
        for (int b = 0; b < 16; ++b) acc[b] = 0.f;
        const int k0 = wave * 256 + kp;
        for (int i0 = 0; i0 < 128; i0 += 16) {
            float wv[16];
#pragma unroll
            for (int i = 0; i < 16; ++i) wv[i] = __builtin_nontemporal_load(W + (size_t)(k0 + 2 * (i0 + i)) * NMOD);
            asm volatile("" ::: "memory");
#pragma unroll
            for (int i = 0; i < 16; ++i) { const int k = k0 + 2 * (i0 + i);
                const f32x4 c0 = *(const LAS f32x4*)(cT + k * 16), c1 = *(const LAS f32x4*)(cT + k * 16 + 4), c2 = *(const LAS f32x4*)(cT + k * 16 + 8), c3 = *(const LAS f32x4*)(cT + k * 16 + 12);
                const float w = wv[i];
                acc[0] += c0.x * w; acc[1] += c0.y * w; acc[2] += c0.z * w; acc[3] += c0.w * w;
                acc[4] += c1.x * w; acc[5] += c1.y * w; acc[6] += c1.z * w; acc[7] += c1.w * w;
                acc[8] += c2.x * w; acc[9] += c2.y * w; acc[10] += c2.z * w; acc[11] += c2.w * w;
                acc[12] += c3.x * w; acc[13] += c3.y * w; acc[14] += c3.z * w; acc[15] += c3.w * w; }
        }
        __syncthreads();
#pragma unroll
        for (int b = 0; b < 16; ++b) red[((wave * 2 + kp) * 16 + b) * 32 + cl] = acc[b];
        __syncthreads();
        { const int b = tid >> 5, n = tid & 31; float s = 0.f;
#pragma unroll
            for (int p = 0; p < 16; ++p) s += red[(p * 16 + b) * 32 + n];
            const int col = n0 + n, j = col >> 11, d = col & 2047;
            s += a.in[3][l * NMOD + col];
            float o = s;
            if (j == 1) o = a.in[4][l * DM + d] * (1.f + s);
            else if (j == 2) o = s * a.in[5][l * DM + d];
            else if (j == 4) o = a.in[6][l * DM + d] * (1.f + s);
            else if (j == 5) o = s * a.in[7][l * DM + d];
            modv[(size_t)(l * 16 + b) * NMOD + col] = o; }
        __syncthreads();
    }
}
__device__ __forceinline__ void ph_tables(const Args& a, int bid, int nb, int tid) {
    float* cosA = (float*)(a.ws + WS_ROPE); float* sinA = cosA + 2048 * 64; float* cosB = sinA + 2048 * 64; float* sinB = cosB + 2048 * 64;
    for (int i = bid * NTHR + tid; i < 2048 * 64; i += nb * NTHR) {
        const int pos = i >> 6, j = i & 63;
        {
            const int p = (j < 32) ? (pos >> 6) : (pos & 63), fj = j & 31;
            const float inv = 1.0f / powf(10000.0f, (float)(2 * fj) / 64.0f);
            const float ang = (float)p * inv;
            const double rev = (double)ang * 0.15915494309189535; const float fr = (float)(rev - rint(rev));
            cosA[i] = __builtin_amdgcn_cosf(fr); sinA[i] = __builtin_amdgcn_sinf(fr);
        }
        {
            const float inv = 1.0f / powf(10000.0f, (float)(2 * j) / 128.0f);
            const float ang = (float)pos * inv;
            const double rev = (double)ang * 0.15915494309189535; const float fr = (float)(rev - rint(rev));
            cosB[i] = __builtin_amdgcn_cosf(fr); sinB[i] = __builtin_amdgcn_sinf(fr);
        }
    }
    float* gcat = (float*)(a.ws + WS_GCAT);
    for (int i = bid * NTHR + tid; i < DEPTH * 2048; i += nb * NTHR) {
        const int l = i >> 11, k = i & 2047;
        gcat[i] = (k < 1024) ? a.in[12][l * 1024 + k] : a.in[13][l * 1024 + (k - 1024)];
    }
}

template <int YMODE, int HAS_H> struct RowIn { f32x4 x[8]; v2u y0[YMODE >= 1 ? 8 : 1]; v2u y1[YMODE == 2 ? 8 : 1]; f32x4 g[YMODE >= 1 ? 8 : 1]; f32x4 a[HAS_H ? 8 : 1]; f32x4 s[HAS_H ? 8 : 1]; float w0, w1; };
template <int YMODE, int HAS_H, bool XB  >
__device__ __forceinline__ void row_load(RowIn<YMODE, HAS_H>& R, int t, int lane, const float* __restrict__ xin, const bf16* __restrict__ ysrc, const int* __restrict__ slot_of, const float* __restrict__ topw,
                                         const float* __restrict__ Gv, const float* __restrict__ Av, const float* __restrict__ Sv) {
    v2u xb[8];
    if constexpr (XB) { const v2u* xp = (const v2u*)((const bf16*)xin + (size_t)t * DM) + lane;
#pragma unroll
        for (int j = 0; j < 8; ++j) xb[j] = xp[64 * j];
    } else { const f32x4* xp = (const f32x4*)(xin + (size_t)t * DM) + lane;
#pragma unroll
        for (int j = 0; j < 8; ++j) R.x[j] = __builtin_nontemporal_load(xp + 64 * j); }
    if constexpr (YMODE == 1) {
        const v2u* yp = (const v2u*)(ysrc + (size_t)t * DM) + lane;
#pragma unroll
        for (int j = 0; j < 8; ++j) R.y0[j] = yp[64 * j];
    } else if constexpr (YMODE == 2) {
        const int s0 = slot_of[2 * t], s1 = slot_of[2 * t + 1]; R.w0 = topw[2 * t]; R.w1 = topw[2 * t + 1];
        const v2u* y0 = (const v2u*)(ysrc + (size_t)s0 * DM) + lane; const v2u* y1 = (const v2u*)(ysrc + (size_t)s1 * DM) + lane;
#pragma unroll
        for (int j = 0; j < 8; ++j) { R.y0[j] = y0[64 * j]; R.y1[j] = y1[64 * j]; }
    }
    if constexpr (YMODE != 0) { const f32x4* gp = (const f32x4*)Gv + lane;
#pragma unroll
        for (int j = 0; j < 8; ++j) R.g[j] = gp[64 * j]; }
    if constexpr (HAS_H != 0) { const f32x4* ap = (const f32x4*)Av + lane; const f32x4* sp = (const f32x4*)Sv + lane;
#pragma unroll
        for (int j = 0; j < 8; ++j) { R.a[j] = ap[64 * j]; R.s[j] = sp[64 * j]; } }
    asm volatile("" ::: "memory");
    if constexpr (XB) {
#pragma unroll
        for (int j = 0; j < 8; ++j) R.x[j] = (f32x4){bflo(xb[j].x), bfhi(xb[j].x), bflo(xb[j].y), bfhi(xb[j].y)}; }
}
struct Slots { int s0, s1; float w0, w1; };
__device__ __forceinline__ void row_load_moe(RowIn<2, 0>& R, int t, int tn, int lane, const bf16* __restrict__ xin, const bf16* __restrict__ ysrc, const int* __restrict__ slot_of, const float* __restrict__ topw,
                                             const Slots& cur, Slots& nxt, const float* __restrict__ Gv) {
    v2u xb[8];
    const v2u* xp = (const v2u*)(xin + (size_t)t * DM) + lane;
#pragma unroll
    for (int j = 0; j < 8; ++j) xb[j] = xp[64 * j];
    R.w0 = cur.w0; R.w1 = cur.w1;
    const v2u* y0 = (const v2u*)(ysrc + (size_t)cur.s0 * DM) + lane; const v2u* y1 = (const v2u*)(ysrc + (size_t)cur.s1 * DM) + lane;
#pragma unroll
    for (int j = 0; j < 8; ++j) { R.y0[j] = y0[64 * j]; R.y1[j] = y1[64 * j]; }
    const f32x4* gp = (const f32x4*)Gv + lane;
#pragma unroll
    for (int j = 0; j < 8; ++j) R.g[j] = gp[64 * j];
    nxt.s0 = slot_of[2 * tn]; nxt.s1 = slot_of[2 * tn + 1]; nxt.w0 = topw[2 * tn]; nxt.w1 = topw[2 * tn + 1];
    asm volatile("" ::: "memory");
#pragma unroll
    for (int j = 0; j < 8; ++j) R.x[j] = (f32x4){bflo(xb[j].x), bfhi(xb[j].x), bflo(xb[j].y), bfhi(xb[j].y)};
}
template <int YMODE, int HAS_H  , bool ROUTE, bool XB  >
__device__ __forceinline__ void row_finish(RowIn<YMODE, HAS_H>& R, int t, int lane, float* __restrict__ xout, bf16* __restrict__ hout, const LAS float* wrT, int* __restrict__ topi_out, float* __restrict__ topw_out) {
    f32x4 (&x)[8] = R.x;
    if constexpr (YMODE != 0) {
        f32x4 y[8];
#pragma unroll
        for (int j = 0; j < 8; ++j) { const v2u p = R.y0[j];
            if constexpr (YMODE == 1) y[j] = (f32x4){bflo(p.x), bfhi(p.x), bflo(p.y), bfhi(p.y)};
            else { const v2u q = R.y1[j]; const float w0 = R.w0, w1 = R.w1;
                y[j] = (f32x4){w0 * bflo(p.x) + w1 * bflo(q.x), w0 * bfhi(p.x) + w1 * bfhi(q.x), w0 * bflo(p.y) + w1 * bflo(q.y), w0 * bfhi(p.y) + w1 * bfhi(q.y)}; } }
        float ss = 0.f;
#pragma unroll
        for (int j = 0; j < 8; ++j) ss += (y[j].x * y[j].x + y[j].y * y[j].y) + (y[j].z * y[j].z + y[j].w * y[j].w);
        ss = wave_sum(ss);
        const float r = 1.0f / sqrtf(ss * (1.0f / DM) + EPS);
        f32x4* op = (f32x4*)(xout + (size_t)t * DM) + lane; v2u* opb = (v2u*)((bf16*)xout + (size_t)t * DM) + lane;
#pragma unroll
        for (int j = 0; j < 8; ++j) { x[j] = x[j] + R.g[j] * y[j] * r;
            if constexpr (XB) { v2u w; w.x = pk2(x[j].x, x[j].y); w.y = pk2(x[j].z, x[j].w); opb[64 * j] = w; } else __builtin_nontemporal_store(x[j], op + 64 * j); }
    }
    if constexpr (HAS_H != 0) {
        float ss = 0.f;
#pragma unroll
        for (int j = 0; j < 8; ++j) ss += (x[j].x * x[j].x + x[j].y * x[j].y) + (x[j].z * x[j].z + x[j].w * x[j].w);
        ss = wave_sum(ss);
        const float r = 1.0f / sqrtf(ss * (1.0f / DM) + EPS);
        v2u* hp = (v2u*)(hout + (size_t)t * DM) + lane; unsigned* hp8 = (unsigned*)((unsigned char*)hout + (size_t)t * DM) + lane;
#pragma unroll
        for (int j = 0; j < 8; ++j) { x[j] = x[j] * r * R.a[j] + R.s[j];
            if constexpr (HAS_H == 1) { v2u w; w.x = pk2(x[j].x, x[j].y); w.y = pk2(x[j].z, x[j].w); hp[64 * j] = w; }
            else { unsigned w = 0; w = __builtin_amdgcn_cvt_pk_fp8_f32(x[j].x, x[j].y, w, false); w = __builtin_amdgcn_cvt_pk_fp8_f32(x[j].z, x[j].w, w, true); hp8[64 * j] = w; } }
        if constexpr (ROUTE) {
            int i1 = 0, i2 = 0; float v1 = -3.0e38f, v2 = -3.0e38f;
#pragma unroll 1
            for (int e = 0; e < 8; ++e) { float acc = 0.f;
#pragma unroll
                for (int j = 0; j < 8; ++j) { const f32x4 w = *(const LAS f32x4*)(wrT + e * DM + lane * 4 + 256 * j); acc += (x[j].x * w.x + x[j].y * w.y) + (x[j].z * w.z + x[j].w * w.w); }
                const float val = wave_sum(acc);
                if (val > v1) { v2 = v1; i2 = i1; v1 = val; i1 = e; } else if (val > v2) { v2 = val; i2 = e; } }
            const float ex = expf(v2 - v1); const float w1 = 1.0f / (1.0f + ex), w2 = ex / (1.0f + ex);
            if (lane == 0) { topi_out[2 * t] = i1; topi_out[2 * t + 1] = i2; topw_out[2 * t] = w1; topw_out[2 * t + 1] = w2; }
        }
    }
}
#define ROW_LOOP(YM, HH, LOAD, FIN) do { const int _st = nb * NWAVES; for (int _t = bid * NWAVES + wave; _t < T; _t += _st) { RowIn<YM, HH> _A; LOAD(_A, _t); FIN(_A, _t); } } while (0)

__device__ __forceinline__ void ph_prep(const Args& a, int l, int bid, int nb, int tid) {
    bf16* qkv = (bf16*)(a.ws + WS_QKV);
    const float* cosA = (const float*)(a.ws + WS_ROPE); const float* sinA = cosA + 2048 * 64; const float* cosB = sinA + 2048 * 64; const float* sinB = cosB + 2048 * 64;
    const int wave = __builtin_amdgcn_readfirstlane(tid >> 6), lane = tid & 63;
    const int jA = (lane >> 5) * 32 + 2 * (lane & 15), jB = 2 * (lane & 31);
    const float sgA = (lane & 16) ? 1.f : -1.f, sgB = (lane & 32) ? 1.f : -1.f;
    const f32x2 gk = *(const f32x2*)(a.in[10] + l * HD + 2 * lane);
    const int st = nb * NWAVES;
    for (int t0 = bid * NWAVES + wave; t0 < T; t0 += 2 * st) {
        unsigned w[2][4]; f32x2 cA[2], sA[2], cB[2], sB[2]; unsigned* p[2][4]; const int nt = (t0 + st < T) ? 2 : 1;
#pragma unroll
        for (int q = 0; q < 2; ++q) { const int t = q < nt ? t0 + q * st : t0; const int pos = t & (SEQ - 1); bf16* row = qkv + (size_t)t * NQKV;
            p[q][0] = (unsigned*)(row + KA_OFF) + lane; p[q][1] = (unsigned*)(row + KA_OFF + HD) + lane; p[q][2] = (unsigned*)(row + KB_OFF) + lane; p[q][3] = (unsigned*)(row + KB_OFF + HD) + lane;
#pragma unroll
            for (int h = 0; h < 4; ++h) w[q][h] = *p[q][h];
            cA[q] = *(const f32x2*)(cosA + pos * 64 + jA); sA[q] = *(const f32x2*)(sinA + pos * 64 + jA); cB[q] = *(const f32x2*)(cosB + pos * 64 + jB); sB[q] = *(const f32x2*)(sinB + pos * 64 + jB); }
        asm volatile("" ::: "memory");
#pragma unroll
        for (int q = 0; q < 2; ++q) if (q < nt) {
#pragma unroll
            for (int h = 0; h < 2; ++h) {
                float x0 = bflo(w[q][h]), x1 = bfhi(w[q][h]);
                const float ss = wave_sum(x0 * x0 + x1 * x1); const float r = 1.0f / sqrtf(ss * (1.0f / HD) + EPS);
                x0 *= r * gk.x; x1 *= r * gk.y;
                const float p0 = __shfl_xor(x0, 16), p1 = __shfl_xor(x1, 16);
                *p[q][h] = pk2(x0 * cA[q].x + sgA * p0 * sA[q].x, x1 * cA[q].y + sgA * p1 * sA[q].y); }
#pragma unroll
            for (int h = 2; h < 4; ++h) {
                const float x0 = bflo(w[q][h]), x1 = bfhi(w[q][h]);
                const float p0 = __shfl_xor(x0, 32), p1 = __shfl_xor(x1, 32);
                *p[q][h] = pk2(x0 * cB[q].x + sgB * p0 * sB[q].x, x1 * cB[q].y + sgB * p1 * sB[q].y); }
        }
    }
}

__device__ __forceinline__ void ph_attn_norm(const Args& a, int bid, int nb, int tid) {
    const f32x4* ssq = (const f32x4*)(a.ws + WS_SSQ); f32x2* fac = (f32x2*)(a.ws + WS_FAC);
    for (int t = bid * NTHR + tid; t < T; t += nb * NTHR) {
        const f32x4 a0 = ssq[t * 4], a1 = ssq[t * 4 + 1], b0 = ssq[t * 4 + 2], b1 = ssq[t * 4 + 3];
        const float sa = ((a0.x + a0.y) + (a0.z + a0.w)) + ((a1.x + a1.y) + (a1.z + a1.w)), sb = ((b0.x + b0.y) + (b0.z + b0.w)) + ((b1.x + b1.y) + (b1.z + b1.w));
        fac[t] = (f32x2){1.0f / sqrtf(sa * (1.0f / 1024.f) + EPS), 1.0f / sqrtf(sb * (1.0f / 1024.f) + EPS)};
    }
}

__device__ __forceinline__ void ph_route_cnt(const Args& a, LAS unsigned char* lds, int bid, int nb, int tid) {
    const int* topi = (const int*)(a.ws + WS_TOPI); int* cnt = (int*)(a.ws + WS_CNT);
    LAS int* cn = (LAS int*)lds;
    for (int c = bid; c < 256; c += nb) {
        if (tid < 8) cn[tid] = 0;
        __syncthreads();
        if (tid < 256) atomicAdd((int*)&cn[topi[c * 256 + tid]], 1);
        __syncthreads();
        if (tid < 8) cnt[c * 8 + tid] = cn[tid];
        __syncthreads();
    }
}
__device__ __forceinline__ void ph_route_build(const Args& a, LAS unsigned char* lds, int bid, int nb, int tid) {
    const int* topi = (const int*)(a.ws + WS_TOPI); const int* cnt = (const int*)(a.ws + WS_CNT);
    int* rowl = (int*)(a.ws + WS_ROWL); int* slot = (int*)(a.ws + WS_SLOT); int* tile = (int*)(a.ws + WS_TILE);
    LAS int* sh = (LAS int*)lds;
    LAS int* scnt = sh + 32;
    LAS int* stop = scnt + 2048;
    for (int c = bid; c < 256; c += nb) {
        for (int i = tid; i < 2048; i += NTHR) scnt[i] = cnt[i];
        if (tid < 256) stop[tid] = topi[c * 256 + tid];
        __syncthreads();
        if (tid < 8) { int tot = 0, base = 0; for (int cc = 0; cc < 256; ++cc) { const int v = scnt[cc * 8 + tid]; if (cc < c) base += v; tot += v; } sh[tid] = tot; sh[8 + tid] = base; }
        __syncthreads();
        if (tid == 0) { int o = 0; for (int e = 0; e < 8; ++e) { sh[16 + e] = o; o += (sh[e] + 255) & ~255; } sh[24] = o; }
        __syncthreads();
        if (tid < 8) { int pos = sh[16 + tid] + sh[8 + tid];
            for (int i = 0; i < 256; ++i) if (stop[i] == tid) { rowl[pos] = c * 128 + (i >> 1); slot[c * 256 + i] = pos; ++pos; } }
        if (c < 8) { const int tot = sh[c], o = sh[16 + c], padded = (tot + 255) & ~255;
            for (int i = tid; i < padded - tot; i += NTHR) rowl[o + tot + i] = 0;
            for (int i = tid; i < padded / 256; i += NTHR) tile[o / 256 + i] = c; }
        if (c == 0 && tid == 0) tile[512] = sh[24] / 256;
        __syncthreads();
    }
}


namespace pg8 {
constexpr int BM = 256, BK = 64, HALF = 128, HTB = HALF * BK * 2, STAGE_BYTES = 8 * HTB, NXCD = 8;
__host__ __device__ __forceinline__ int lds_byte(int r, int c) { const int st = (r >> 4) * 2 + (c >> 5), rr = r & 15, cc = c & 31, ob = rr * 64 + cc * 2; return st * 1024 + (ob ^ (((ob >> 9) & 1) << 5)); }
__host__ __device__ __forceinline__ void stage_rc(int b, int& R, int& C) { const int st = b / 1024, sb = b % 1024, swz = sb ^ (((sb >> 9) & 1) << 5); R = (st >> 1) * 16 + swz / 64; C = (st & 1) * 32 + (swz % 64) / 2; }
__host__ __device__ __forceinline__ int perm32(int rho) { const int n = rho >> 4, i = rho & 15; return 8 * (i >> 2) + 4 * n + (i & 3); }
struct Unit { int pm, pn; };
struct StaticOrder {
    int nM, nN, nwg, G, c, WGM = 4, r0 = 0, r1 = 1 << 30;
    __device__ void init(int nM_, int nN_, int G_, int c_, int wgm = 4) { nM = nM_; nN = nN_; nwg = nM * nN; G = G_; c = c_; WGM = wgm; }
    __device__ bool next(int i_, Unit& u) const {
        const int i = i_ + r0; if (i >= r1) return false;
        const long L = (long)i * G + c; if (L >= nwg) return false;
        int wgid = (int)L; { const int q = nwg / NXCD, r = nwg % NXCD, xcd = wgid % NXCD, off = wgid / NXCD; wgid = (xcd < r ? xcd * (q + 1) : r * (q + 1) + (xcd - r) * q) + off; }
        const int nig = WGM * nN, gid = wgid / nig, fm = gid * WGM, gsz = (nM - fm) < WGM ? (nM - fm) : WGM;
        u.pm = fm + ((wgid % nig) % gsz); u.pn = (wgid % nig) / gsz; return true;
    }
};
__device__ __forceinline__ unsigned cvt_pk_bf16(float lo, float hi) { unsigned r; asm volatile("v_cvt_pk_bf16_f32 %0, %1, %2" : "=v"(r) : "v"(lo), "v"(hi)); return r; }
struct EpiPlain {
    static constexpr bool MID = false;
    bf16* O; int ldc; float sc;
    __device__ __forceinline__ void operator()(const f32x4 (&acc)[2][2][4][2], const Unit& u, int wr, int wc, int fr, int fq) const {
        const int row0 = u.pm * BM + wr * 64 + fr, col0 = u.pn * BM + wc * 32 + 8 * fq;
#pragma unroll
        for (int ai = 0; ai < 2; ++ai)
#pragma unroll
            for (int m = 0; m < 4; ++m) { bf16* rowp = O + (size_t)(row0 + ai * HALF + m * 16) * ldc + col0;
#pragma unroll
                for (int bj = 0; bj < 2; ++bj) { const f32x4 v0 = acc[ai][bj][m][0] * sc, v1 = acc[ai][bj][m][1] * sc;
                    v4u w; w.x = cvt_pk_bf16(v0[0], v0[1]); w.y = cvt_pk_bf16(v0[2], v0[3]); w.z = cvt_pk_bf16(v1[0], v1[1]); w.w = cvt_pk_bf16(v1[2], v1[3]);
                    *(v4u*)(rowp + bj * HALF) = w; } }
    }
};
struct EpiRowScale {
    static constexpr bool MID = true;
    bf16* O; int ldc; const float* fac;
    __device__ __forceinline__ void operator()(const f32x4 (&acc)[2][2][4][2], const Unit& u, int wr, int wc, int fr, int fq, const float (&fw)[2][4]) const {
        const int row0 = u.pm * BM + wr * 64 + fr, col0 = u.pn * BM + wc * 32 + 8 * fq;
#pragma unroll
        for (int ai = 0; ai < 2; ++ai)
#pragma unroll
            for (int m = 0; m < 4; ++m) { bf16* rowp = O + (size_t)(row0 + ai * HALF + m * 16) * ldc + col0; const float sc = fw[ai][m];
#pragma unroll
                for (int bj = 0; bj < 2; ++bj) { const f32x4 v0 = acc[ai][bj][m][0] * sc, v1 = acc[ai][bj][m][1] * sc;
                    v4u w; w.x = cvt_pk_bf16(v0[0], v0[1]); w.y = cvt_pk_bf16(v0[2], v0[3]); w.z = cvt_pk_bf16(v1[0], v1[1]); w.w = cvt_pk_bf16(v1[2], v1[3]);
                    *(v4u*)(rowp + bj * HALF) = w; } }
    }
};
__device__ __forceinline__ float silu_mul(float g, float u) { return g * __builtin_amdgcn_rcpf(1.0f + __builtin_amdgcn_exp2f(-1.4426950408889634f * g)) * u; }
struct EpiSwiglu {
    static constexpr bool MID = false;
    bf16* O; int ldc;
    __device__ __forceinline__ void operator()(const f32x4 (&acc)[2][2][4][2], const Unit& u, int wr, int wc, int fr, int fq) const {
        const int row0 = u.pm * BM + wr * 64 + fr, col0 = u.pn * HALF + wc * 32 + 8 * fq;
#pragma unroll
        for (int ai = 0; ai < 2; ++ai)
#pragma unroll
            for (int m = 0; m < 4; ++m) { bf16* rowp = O + (size_t)(row0 + ai * HALF + m * 16) * ldc + col0;
                const f32x4 g0 = acc[ai][0][m][0], g1 = acc[ai][0][m][1], u0 = acc[ai][1][m][0], u1 = acc[ai][1][m][1];
                v4u w; w.x = cvt_pk_bf16(silu_mul(g0[0], u0[0]), silu_mul(g0[1], u0[1])); w.y = cvt_pk_bf16(silu_mul(g0[2], u0[2]), silu_mul(g0[3], u0[3]));
                w.z = cvt_pk_bf16(silu_mul(g1[0], u1[0]), silu_mul(g1[1], u1[1])); w.w = cvt_pk_bf16(silu_mul(g1[2], u1[2]), silu_mul(g1[3], u1[3]));
                *(v4u*)rowp = w; }
    }
};
struct EpiSwiglu8 {
    static constexpr bool MID = false;
    unsigned char* O; int ldc; float sc;
    static __device__ __forceinline__ f32x4 swiglu4(f32x4 g, f32x4 u, float kk, float c2) {
        const f32x4 t = g * u, x = g * kk; f32x4 e, r;
#pragma unroll
        for (int i = 0; i < 4; ++i) e[i] = __builtin_amdgcn_exp2f(x[i]);
        const f32x4 d = e * c2 + c2;
#pragma unroll
        for (int i = 0; i < 4; ++i) r[i] = __builtin_amdgcn_rcpf(d[i]);
        return t * r;
    }
    __device__ __forceinline__ void operator()(const f32x4 (&acc)[2][2][4][2], const Unit& u, int wr, int wc, int fr, int fq) const {
        const int row0 = u.pm * BM + wr * 64 + fr + (fq & 1) * 16, col0 = u.pn * HALF + wc * 32 + 8 * (fq & 2);
        const float kk = -1.4426950408889634f * sc, c2 = 1.0f / (sc * sc);
#pragma unroll
        for (int ai = 0; ai < 2; ++ai)
#pragma unroll
            for (int mp = 0; mp < 4; mp += 2) { v2u w[2];
#pragma unroll
                for (int q = 0; q < 2; ++q) { const int m = mp + q;
                    const f32x4 o0 = swiglu4(acc[ai][0][m][0], acc[ai][1][m][0], kk, c2), o1 = swiglu4(acc[ai][0][m][1], acc[ai][1][m][1], kk, c2);
                    w[q].x = 0; w[q].y = 0;
                    w[q].x = __builtin_amdgcn_cvt_pk_fp8_f32(o0[0], o0[1], w[q].x, false); w[q].x = __builtin_amdgcn_cvt_pk_fp8_f32(o0[2], o0[3], w[q].x, true);
                    w[q].y = __builtin_amdgcn_cvt_pk_fp8_f32(o1[0], o1[1], w[q].y, false); w[q].y = __builtin_amdgcn_cvt_pk_fp8_f32(o1[2], o1[3], w[q].y, true); }
                const auto rx = __builtin_amdgcn_permlane16_swap(w[0].x, w[1].x, false, false), ry = __builtin_amdgcn_permlane16_swap(w[0].y, w[1].y, false, false);
                v4u o; o.x = rx[0]; o.y = ry[0]; o.z = rx[1]; o.w = ry[1];
                *(v4u*)(O + (size_t)(row0 + ai * HALF + mp * 16) * ldc + col0) = o; }
    }
};
typedef int i32x8 __attribute__((ext_vector_type(8)));
typedef int i32x4 __attribute__((ext_vector_type(4)));
typedef short bf16x16 __attribute__((ext_vector_type(16)));
__device__ __forceinline__ i32x8 cat8(bf16x8 lo, bf16x8 hi) { const i32x4 a = __builtin_bit_cast(i32x4, lo), b = __builtin_bit_cast(i32x4, hi); return (i32x8){a[0], a[1], a[2], a[3], b[0], b[1], b[2], b[3]}; }
template <class Epi, bool GATHER, bool EXPERT, bool FP8 = false>
__device__ __forceinline__ void gemm_phase(LAS unsigned char* lds, const char* Abase, const int* rowlist, const char* Bbase, const int* tile_expert, size_t bstride_e, int Kelems, const StaticOrder& S, const Epi& E) {
    const int K = FP8 ? Kelems / 2 : Kelems;
    const int tid = fresh_tid(), wid = __builtin_amdgcn_readfirstlane(tid >> 6), lane = tid & 63, wr = wid >> 2, wc = wid & 3, fr = lane & 15, fq = lane >> 4;
    const int nt = K / BK;
    unsigned voffA[2], voffB[2];
#pragma unroll
    for (int i = 0; i < 2; ++i) { int R, C; stage_rc(tid * 16 + i * 8192, R, C); const int Rb = (R & ~31) + perm32(R & 31);
        voffA[i] = GATHER ? (unsigned)(R * 65536 + C * 2) : (unsigned)(R * K + C) * 2u; voffB[i] = (unsigned)(Rb * K + C) * 2u; }
    const size_t kstep = (size_t)(BK * 2), hstep = (size_t)HALF * K * 2, tstep = 2 * hstep;
    const unsigned ldsw = (unsigned)wid * 1024u;
    const int aoff = lds_byte(wr * 64 + fr, fq * 8), boff = lds_byte(wc * 32 + fr, fq * 8);
    LAS unsigned* rtab = (LAS unsigned*)(lds + STAGE_BYTES + 1024);
    LAS int* etab = (LAS int*)(lds + STAGE_BYTES + 4096);
    LAS float* ftab = (LAS float*)(lds + STAGE_BYTES + 8192);
    const unsigned rowbytes = (unsigned)K * 2u;
#define PG8_SA(b, h) (((b) * 2 + (h)) * HTB)
#define PG8_SB(b, h) ((4 + (b) * 2 + (h)) * HTB)
#define PG8_STAGE(bufoff, gbase, voff) do { _Pragma("unroll") for (int _i = 0; _i < 2; ++_i) { asm volatile("" : "+v"((voff)[_i])); \
        __builtin_amdgcn_global_load_lds((const unsigned*)((const char*)(gbase) + (voff)[_i]), (LAS unsigned*)(lds + (bufoff) + ldsw + _i * 8192), 16, 0, 0); } } while (0)
#define PG8_STAGE_A(bufoff, pa, par, kb, h) do { _Pragma("unroll") for (int _i = 0; _i < 2; ++_i) { if constexpr (GATHER) asm volatile("" : "+v"(ra[h][_i])); else asm volatile("" : "+v"(voffA[_i])); \
        const char* _p = GATHER ? Abase + (kb) + ra[h][_i] : (pa) + (kb) + (size_t)(h) * hstep + voffA[_i]; \
        __builtin_amdgcn_global_load_lds((const unsigned*)_p, (LAS unsigned*)(lds + (bufoff) + ldsw + _i * 8192), 16, 0, 0); } } while (0)
#define PG8_LDA(dst, b, h) do { _Pragma("unroll") for (int m = 0; m < 4; ++m) { const bf16x8 _l = *(const LAS bf16x8*)(lds + PG8_SA(b, h) + aoff + m * 2048), _h = *(const LAS bf16x8*)(lds + PG8_SA(b, h) + aoff + m * 2048 + 1024); \
        dst[m] = __builtin_shufflevector(_l, _h, 0, 1, 2, 3, 4, 5, 6, 7, 8, 9, 10, 11, 12, 13, 14, 15); } } while (0)
#define PG8_LDB(dst, b, h) do { _Pragma("unroll") for (int n = 0; n < 2; ++n) { const bf16x8 _l = *(const LAS bf16x8*)(lds + PG8_SB(b, h) + boff + n * 2048), _h = *(const LAS bf16x8*)(lds + PG8_SB(b, h) + boff + n * 2048 + 1024); \
        dst[n] = __builtin_shufflevector(_l, _h, 0, 1, 2, 3, 4, 5, 6, 7, 8, 9, 10, 11, 12, 13, 14, 15); } } while (0)
#define PG8_HALF(v, k) __builtin_shufflevector(v, v, 8 * (k), 8 * (k) + 1, 8 * (k) + 2, 8 * (k) + 3, 8 * (k) + 4, 8 * (k) + 5, 8 * (k) + 6, 8 * (k) + 7)
#define PG8_MMA(ai, bj, At, Bt) do { __builtin_amdgcn_s_setprio(1); _Pragma("unroll") for (int m = 0; m < 4; ++m) _Pragma("unroll") for (int n = 0; n < 2; ++n) { \
        if constexpr (FP8) asm volatile("v_mfma_f32_16x16x128_f8f6f4 %0, %1, %2, %0" : "+v"(acc[ai][bj][m][n]) : "v"(__builtin_bit_cast(i32x8, Bt[n])), "v"(__builtin_bit_cast(i32x8, At[m]))); \
        else { acc[ai][bj][m][n] = __builtin_amdgcn_mfma_f32_16x16x32_bf16(PG8_HALF(Bt[n], 0), PG8_HALF(At[m], 0), acc[ai][bj][m][n], 0, 0, 0); \
               acc[ai][bj][m][n] = __builtin_amdgcn_mfma_f32_16x16x32_bf16(PG8_HALF(Bt[n], 1), PG8_HALF(At[m], 1), acc[ai][bj][m][n], 0, 0, 0); } } \
        __builtin_amdgcn_s_setprio(0); } while (0)
#define PG8_WAIT_V(n) asm volatile("s_waitcnt vmcnt(" #n ")" ::: "memory")
#define PG8_WAIT_L(n) asm volatile("s_waitcnt lgkmcnt(" #n ")" ::: "memory")
#define PG8_BAR __builtin_amdgcn_s_barrier()
#define PG8_SCHED __builtin_amdgcn_sched_barrier(0)
#define PG8_RTAB(par, u) do { if (GATHER && wid < 4) __builtin_amdgcn_global_load_lds((const unsigned*)(rowlist + (u).pm * BM + wid * 64 + lane), (LAS unsigned*)(rtab + (par) * 256 + wid * 64), 4, 0, 0); } while (0)
#define PG8_FTAB(par, u) do { if constexpr (Epi::MID) __builtin_amdgcn_global_load_lds((const unsigned*)(E.fac + (size_t)(u).pm * BM * 2 + wid * 64 + lane), (LAS unsigned*)(ftab + (par) * 512 + wid * 64), 4, 0, 0); } while (0)
#define PG8_RA(par) do { if constexpr (GATHER) { _Pragma("unroll") for (int _h = 0; _h < 2; ++_h) _Pragma("unroll") for (int _i = 0; _i < 2; ++_i) \
        ra[_h][_i] = rtab[(par) * 256 + _h * HALF + (voffA[_i] >> 16)] * rowbytes + (voffA[_i] & 0xffffu); } } while (0)
#define PG8_BPTR(u) (Bbase + (EXPERT ? (size_t)__builtin_amdgcn_readfirstlane(etab[(u).pm]) * bstride_e : (size_t)0) + (size_t)(u).pn * tstep)
    Unit cur, nxt; int ui = 0;
    if (!S.next(0, cur)) return;
    f32x4 acc[2][2][4][2];
#pragma unroll
    for (int a = 0; a < 2; ++a)
#pragma unroll
        for (int b = 0; b < 2; ++b)
#pragma unroll
            for (int m = 0; m < 4; ++m)
#pragma unroll
                for (int n = 0; n < 2; ++n) acc[a][b][m][n] = (f32x4){0.f, 0.f, 0.f, 0.f};
    bf16x16 At[4], B0[2], B1[2];
    if (EXPERT) etab[tid] = tile_expert[tid];
    float fwr[2][4] = {};
    unsigned ra[2][2] = {};
    if (GATHER || EXPERT || Epi::MID) { PG8_RTAB(0, cur); PG8_FTAB(0, cur); asm volatile("s_waitcnt vmcnt(0) lgkmcnt(0)" ::: "memory"); __syncthreads(); }
    PG8_RA(0);
    const char* cA = Abase + (GATHER ? (size_t)0 : (size_t)cur.pm * tstep); const char* cB = PG8_BPTR(cur);
    PG8_STAGE(PG8_SB(0, 0), cB, voffB); PG8_STAGE(PG8_SB(0, 1), cB + hstep, voffB); PG8_STAGE_A(PG8_SA(0, 0), cA, 0, 0, 0); PG8_STAGE_A(PG8_SA(0, 1), cA, 0, 0, 1);
    if (wr == 1) PG8_BAR;
    PG8_WAIT_V(2); PG8_BAR;
    PG8_STAGE(PG8_SB(1, 0), cB + kstep, voffB); PG8_STAGE_A(PG8_SA(1, 0), cA, 0, kstep, 0); PG8_STAGE(PG8_SB(1, 1), cB + hstep + kstep, voffB);
    PG8_WAIT_V(6); PG8_BAR;
    for (;;) {
        const bool has_next = S.next(ui + 1, nxt);
        const int pc = ui & 1, pn_ = has_next ? (pc ^ 1) : pc;
        if (has_next) { PG8_RTAB(pc ^ 1, nxt); PG8_FTAB(pc ^ 1, nxt); }
        const char* nA = GATHER ? Abase : (has_next ? Abase + (size_t)nxt.pm * tstep : cA); const char* nB = has_next ? PG8_BPTR(nxt) : cB;
        for (int t = 0; t < nt; t += 2) {
            const bool last = (t == nt - 2);
            if constexpr (Epi::MID) { if (t == (nt >> 1)) {
#pragma unroll
                for (int ai = 0; ai < 2; ++ai)
#pragma unroll
                    for (int m = 0; m < 4; ++m) { const f32x2 f = *(const LAS f32x2*)(ftab + pc * 512 + (ai * HALF + wr * 64 + m * 16 + fr) * 2); const float ratio = f.x / f.y; fwr[ai][m] = f.y;
#pragma unroll
                        for (int bj = 0; bj < 2; ++bj)
#pragma unroll
                            for (int n = 0; n < 2; ++n) acc[ai][bj][m][n] *= ratio; } } }
            const size_t k1 = (size_t)(t + 1) * kstep, k2 = last ? (size_t)0 : (size_t)(t + 2) * kstep, k3 = k2 + kstep;
            const char* a2 = last ? nA : cA; const int p2 = last ? pn_ : pc;
            const char* b2 = last ? nB : cB + (size_t)(t + 2) * kstep; const char* b3 = b2 + kstep;
            PG8_LDB(B0, 0, 0); PG8_LDB(B1, 0, 1); PG8_SCHED; PG8_LDA(At, 0, 0); PG8_STAGE_A(PG8_SA(1, 1), cA, pc, k1, 1);
            if constexpr (GATHER) { if (last) PG8_RA(pn_); }
            PG8_WAIT_V(8); PG8_WAIT_L(0); PG8_BAR; PG8_MMA(0, 0, At, B0); PG8_MMA(0, 1, At, B1); PG8_BAR; PG8_SCHED;
            PG8_LDA(At, 0, 1); PG8_STAGE(PG8_SB(0, 0), b2, voffB); PG8_STAGE(PG8_SB(0, 1), b2 + hstep, voffB); PG8_STAGE_A(PG8_SA(0, 0), a2, p2, k2, 0);
            PG8_WAIT_V(8); PG8_WAIT_L(0); PG8_BAR; PG8_MMA(1, 0, At, B0); PG8_MMA(1, 1, At, B1); PG8_BAR; PG8_SCHED;
            PG8_LDB(B0, 1, 0); PG8_LDB(B1, 1, 1); PG8_SCHED; PG8_LDA(At, 1, 0); PG8_STAGE_A(PG8_SA(0, 1), a2, p2, k2, 1);
            PG8_WAIT_V(8); PG8_WAIT_L(0); PG8_BAR; PG8_MMA(0, 0, At, B0); PG8_MMA(0, 1, At, B1); PG8_BAR; PG8_SCHED;
            PG8_LDA(At, 1, 1); PG8_STAGE(PG8_SB(1, 0), b3, voffB); PG8_STAGE(PG8_SB(1, 1), b3 + hstep, voffB); PG8_STAGE_A(PG8_SA(1, 0), a2, p2, k3, 0);
            PG8_WAIT_V(8); PG8_WAIT_L(0); PG8_BAR; PG8_MMA(1, 0, At, B0); PG8_MMA(1, 1, At, B1); PG8_BAR; PG8_SCHED;
        }
        if (wr == 0) PG8_BAR;
        if constexpr (FP8) asm volatile("s_nop 15\n\ts_nop 15" ::: "memory");
        if constexpr (Epi::MID) E(acc, cur, wr, wc, fr, fq, fwr); else E(acc, cur, wr, wc, fr, fq);
        if (!has_next) break;
#pragma unroll
        for (int a = 0; a < 2; ++a)
#pragma unroll
            for (int b = 0; b < 2; ++b)
#pragma unroll
                for (int m = 0; m < 4; ++m)
#pragma unroll
                    for (int n = 0; n < 2; ++n) acc[a][b][m][n] = (f32x4){0.f, 0.f, 0.f, 0.f};
        cur = nxt; cA = nA; cB = nB; ++ui;
        if (wr == 1) PG8_BAR;
    }
    PG8_WAIT_V(0);
    PG8_BAR;
#undef PG8_SA
#undef PG8_SB
#undef PG8_STAGE
#undef PG8_STAGE_A
#undef PG8_LDA
#undef PG8_LDB
#undef PG8_MMA
#undef PG8_HALF
#undef PG8_WAIT_V
#undef PG8_WAIT_L
#undef PG8_BAR
#undef PG8_SCHED
#undef PG8_RTAB
#undef PG8_BPTR
#undef PG8_RA
#undef PG8_FTAB
}
}


namespace att {
constexpr int D = 128, NW = 8, QBLK = 32, KVBLK = 64;
constexpr float SCALE = 0.088388347648318440f, THR = 8.f;
constexpr int LDQ = NQKV, LDK = NQKV, LDO = DM;
constexpr size_t SHM_V = KVBLK * D * 2, SHM_K = KVBLK * D * 2, SHM_ATTN = 2 * SHM_V + 2 * SHM_K + NW * 64 * 4;
using s16x4 = __attribute__((ext_vector_type(4))) short;
#define KSWZ(row, colB) ((row) * 256 + ((colB) ^ (((row) & 7) << 4)))
#define SBAR() __builtin_amdgcn_sched_barrier(0)
__device__ __forceinline__ int crow(int r, int hi) { return (r & 3) + 8 * (r >> 2) + 4 * hi; }
__device__ __forceinline__ unsigned cvtpk(float lo, float hi) { unsigned r; asm volatile("v_cvt_pk_bf16_f32 %0, %1, %2" : "=v"(r) : "v"(lo), "v"(hi)); return r; }
template <bool WIN>
__device__ __forceinline__ void partialSM(f32x16& p0, f32x16& p1, float& m_reg, float& mn, float& alpha, int kq, int hi) {
  constexpr float C = SCALE * 1.4426950408889634f;
  if constexpr (WIN) {
#pragma unroll
    for (int r = 0; r < 16; ++r) { const int d0 = kq + crow(r, hi), d1 = d0 + 32; if (d0 < -128 || d0 > 128) p0[r] = -1.0e30f; if (d1 < -128 || d1 > 128) p1[r] = -1.0e30f; }
  }
  float pmax = p0[0];
#pragma unroll
  for (int r = 1; r < 16; ++r) pmax = fmaxf(pmax, p0[r]);
#pragma unroll
  for (int r = 0; r < 16; ++r) pmax = fmaxf(pmax, p1[r]);
  { auto rr = __builtin_amdgcn_permlane32_swap(__float_as_uint(pmax), __float_as_uint(pmax), false, false);
    pmax = fmaxf(__uint_as_float(rr[0]), __uint_as_float(rr[1])); }
  if (__builtin_expect(__all(pmax - m_reg <= THR / SCALE), 1)) { mn = m_reg; alpha = 1.f; }
  else { mn = fmaxf(m_reg, pmax); alpha = __builtin_amdgcn_exp2f((m_reg - mn) * C); m_reg = mn; }
  const float mnC = -mn * C;
#pragma unroll
  for (int r = 0; r < 16; ++r) p0[r] = fmaf(p0[r], C, mnC);
#pragma unroll
  for (int r = 0; r < 16; ++r) p1[r] = fmaf(p1[r], C, mnC);
#pragma unroll
  for (int r = 0; r < 16; ++r) p0[r] = __builtin_amdgcn_exp2f(p0[r]);
}
__device__ __forceinline__ void finishSM(f32x16& p0, f32x16& p1, float alpha, float& l_reg, bf16x8& pa0, bf16x8& pa1, bf16x8& pa2, bf16x8& pa3) {
#pragma unroll
  for (int r = 0; r < 16; ++r) p1[r] = __builtin_amdgcn_exp2f(p1[r]);
  float ps = 0;
#pragma unroll
  for (int r = 0; r < 16; ++r) ps += p0[r];
#pragma unroll
  for (int r = 0; r < 16; ++r) ps += p1[r];
  { auto rr = __builtin_amdgcn_permlane32_swap(__float_as_uint(ps), __float_as_uint(ps), false, false);
    ps = __uint_as_float(rr[0]) + __uint_as_float(rr[1]); }
  l_reg = l_reg * alpha + ps;
#define PK4(P, BASE, OUT) do { unsigned a0 = cvtpk(P[BASE + 0], P[BASE + 1]), a1 = cvtpk(P[BASE + 2], P[BASE + 3]);   \
    unsigned b0 = cvtpk(P[BASE + 4], P[BASE + 5]), b1 = cvtpk(P[BASE + 6], P[BASE + 7]);                              \
    auto r0 = __builtin_amdgcn_permlane32_swap(a0, b0, false, false); auto r1 = __builtin_amdgcn_permlane32_swap(a1, b1, false, false); \
    v4u w = {r0[0], r1[0], r0[1], r1[1]}; OUT = *reinterpret_cast<bf16x8*>(&w); } while (0)
  PK4(p0, 0, pa0); PK4(p0, 8, pa1); PK4(p1, 0, pa2); PK4(p1, 8, pa3);
#undef PK4
}
__device__ __forceinline__ void qkt(f32x16& p0, f32x16& p1, const bf16* Ks, const bf16x8* qr, int r32, int hi) {
  p0 = f32x16{}; p1 = f32x16{};
#pragma unroll
  for (int d0 = 0; d0 < 8; ++d0) { const int cb = (d0 * 16 + hi * 8) * 2;
    const bf16x8 b0 = *reinterpret_cast<const bf16x8*>((const char*)Ks + KSWZ(r32, cb));
    const bf16x8 b1 = *reinterpret_cast<const bf16x8*>((const char*)Ks + KSWZ(32 + r32, cb));
    p0 = __builtin_amdgcn_mfma_f32_32x32x16_bf16(b0, qr[d0], p0, 0, 0, 0);
    p1 = __builtin_amdgcn_mfma_f32_32x32x16_bf16(b1, qr[d0], p1, 0, 0, 0); }
}
__device__ __forceinline__ int v_st(int k, int c) { const int kk = (k & ~0xC) | ((k & 4) << 1) | ((k & 8) >> 1); return ((kk >> 3) * 4 + (c >> 5)) * 512 + ((kk & 7) * 32 + (c & 31)) * 2; }
__device__ __forceinline__ int v_rd_base(int lane) { return ((lane & 3) << 3) | (((lane >> 2) & 3) << 6) | (((lane >> 4) & 1) << 5) | (((lane >> 5) & 1) << 8); }
constexpr int v_rd_off(int d0, int ks, int half) { return d0 * 512 + ks * 4096 + half * 2048; }
template <int OFF> __device__ __forceinline__ s16x4 tr_read(int vb) {
  s16x4 r; asm volatile("ds_read_b64_tr_b16 %0, %1 offset:%2" : "=&v"(r) : "v"(vb), "i"(OFF) : "memory"); return r;
}
template <int D0> __device__ __forceinline__ void pv_one(f32x16& od, int vb, bf16x8 pa0, bf16x8 pa1, bf16x8 pa2, bf16x8 pa3) {
  const s16x4 l0 = tr_read<v_rd_off(D0, 0, 0)>(vb), h0 = tr_read<v_rd_off(D0, 0, 1)>(vb), l1 = tr_read<v_rd_off(D0, 1, 0)>(vb), h1 = tr_read<v_rd_off(D0, 1, 1)>(vb);
  const s16x4 l2 = tr_read<v_rd_off(D0, 2, 0)>(vb), h2 = tr_read<v_rd_off(D0, 2, 1)>(vb), l3 = tr_read<v_rd_off(D0, 3, 0)>(vb), h3 = tr_read<v_rd_off(D0, 3, 1)>(vb);
  asm volatile("s_waitcnt lgkmcnt(0)" ::: "memory"); SBAR();
#define PK(L, H) (bf16x8){L[0], L[1], L[2], L[3], H[0], H[1], H[2], H[3]}
  od = __builtin_amdgcn_mfma_f32_32x32x16_bf16(pa0, PK(l0, h0), od, 0, 0, 0);
  od = __builtin_amdgcn_mfma_f32_32x32x16_bf16(pa1, PK(l1, h1), od, 0, 0, 0);
  od = __builtin_amdgcn_mfma_f32_32x32x16_bf16(pa2, PK(l2, h2), od, 0, 0, 0);
  od = __builtin_amdgcn_mfma_f32_32x32x16_bf16(pa3, PK(l3, h3), od, 0, 0, 0);
#undef PK
}
__device__ __forceinline__ void pv_d0(f32x16* o, int vb, bf16x8 pa0, bf16x8 pa1, bf16x8 pa2, bf16x8 pa3) {
  pv_one<0>(o[0], vb, pa0, pa1, pa2, pa3); pv_one<1>(o[1], vb, pa0, pa1, pa2, pa3); pv_one<2>(o[2], vb, pa0, pa1, pa2, pa3); pv_one<3>(o[3], vb, pa0, pa1, pa2, pa3);
}
template <bool WIN>
__device__ __forceinline__ void attn_unit(const bf16* __restrict__ Qb, const bf16* __restrict__ Kh, const bf16* __restrict__ Vh, bf16* __restrict__ Ob, int seq, int kq0, const float* __restrict__ m0p,
                                          const float* __restrict__ qg, const float* __restrict__ cosT, const float* __restrict__ sinT, int qpos0, float* __restrict__ Sp, char* lds) {
  const int tid = fresh_tid(), wid = __builtin_amdgcn_readfirstlane(tid >> 6), lane = tid & 63, r32 = lane & 31, hi = lane >> 5;
  bf16* V_lds = (bf16*)lds; bf16* K_lds = (bf16*)(lds + 2 * SHM_V);
  float* ws = (float*)(lds + 2 * SHM_V + 2 * SHM_K) + wid * 64; float* li_l = ws; float* al_l = ws + 32;
  const int wrow = WIN ? (wid & 3) * QBLK : wid * QBLK, wcol = WIN ? (wid >> 2) * D : 0;
  float m_reg = -1e30f, l_reg = 0.f; bf16x8 qr[8];
  if constexpr (WIN) { m_reg = m0p[wid >> 2] * (1.0f / SCALE); l_reg = 1.f; }
  const int kqw = kq0 - (wrow + r32);
  const int tlo_k = wrow - 128 - kq0, thi_k = wrow + 159 - kq0;
#ifndef WIN_SKIP
#define WIN_SKIP 0
#endif
#define NEED(t) (!WIN || !WIN_SKIP || (((t) * KVBLK + KVBLK - 1 >= tlo_k) && ((t) * KVBLK <= thi_k)))
  {
    const bf16* Qw = Qb + (long)(wrow + r32) * LDQ + wcol + hi * 8;
    float x[8][8];
#pragma unroll
    for (int d0 = 0; d0 < 8; ++d0) { const v4u w = *reinterpret_cast<const v4u*>(Qw + d0 * 16);
#pragma unroll
      for (int i = 0; i < 4; ++i) { x[d0][2 * i] = bflo(w[i]); x[d0][2 * i + 1] = bfhi(w[i]); } }
    const int pos = qpos0 + wrow + r32;
    if constexpr (!WIN) {
      float ss = 0.f;
#pragma unroll
      for (int d0 = 0; d0 < 8; ++d0)
#pragma unroll
        for (int e = 0; e < 8; ++e) ss += x[d0][e] * x[d0][e];
      ss += __shfl_xor(ss, 32);
      const float r = 1.0f / sqrtf(ss * (1.0f / D) + 1e-6f);
#pragma unroll
      for (int d0 = 0; d0 < 8; ++d0) { const f32x4 g0 = *(const f32x4*)(qg + d0 * 16 + hi * 8), g1 = *(const f32x4*)(qg + d0 * 16 + hi * 8 + 4);
#pragma unroll
        for (int e = 0; e < 4; ++e) { x[d0][e] *= r * g0[e]; x[d0][4 + e] *= r * g1[e]; } }
    }
#pragma unroll
    for (int pr = 0; pr < 4; ++pr) {
      const int a = WIN ? pr : ((pr >> 1) * 4 + (pr & 1)), b = WIN ? pr + 4 : a + 2;
      const int j0 = WIN ? (pr * 16 + hi * 8) : ((pr >> 1) * 32 + (pr & 1) * 16 + hi * 8);
      const f32x4 c0 = *(const f32x4*)(cosT + pos * 64 + j0), c1 = *(const f32x4*)(cosT + pos * 64 + j0 + 4), s0 = *(const f32x4*)(sinT + pos * 64 + j0), s1 = *(const f32x4*)(sinT + pos * 64 + j0 + 4);
#pragma unroll
      for (int e = 0; e < 8; ++e) { const float c = e < 4 ? c0[e & 3] : c1[e & 3], s = e < 4 ? s0[e & 3] : s1[e & 3]; const float xa = x[a][e], xb = x[b][e];
        x[a][e] = xa * c - xb * s; x[b][e] = xb * c + xa * s; }
    }
#pragma unroll
    for (int d0 = 0; d0 < 8; ++d0) { v4u w;
#pragma unroll
      for (int i = 0; i < 4; ++i) w[i] = cvtpk(x[d0][2 * i], x[d0][2 * i + 1]);
      qr[d0] = __builtin_bit_cast(bf16x8, w); }
  }
  f32x16 o[4] = {};
  const int sr = tid >> 4, sc = (tid & 15) * 8, vst0 = v_st(sr, sc), vst1 = v_st(32 + sr, sc);
  const int vb0 = (int)(uintptr_t)V_lds + v_rd_base(lane);
  constexpr int SD = (WIN && WIN_SKIP) ? 1 : 2;
  struct { bf16x8 vs0, vs1, ks0, ks1; } sr_[SD];
#define SLOAD(i, k0) do { sr_[i].vs0 = *reinterpret_cast<const bf16x8*>(&Vh[(long)((k0) + sr) * LDK + sc]); sr_[i].vs1 = *reinterpret_cast<const bf16x8*>(&Vh[(long)((k0) + 32 + sr) * LDK + sc]); \
    sr_[i].ks0 = *reinterpret_cast<const bf16x8*>(&Kh[(long)((k0) + sr) * LDK + sc]); sr_[i].ks1 = *reinterpret_cast<const bf16x8*>(&Kh[(long)((k0) + 32 + sr) * LDK + sc]); } while (0)
#define SWRITE(b, i) do { *(bf16x8*)((char*)V_lds + (b) * SHM_V + vst0) = sr_[i].vs0;          \
    *(bf16x8*)((char*)V_lds + (b) * SHM_V + vst1) = sr_[i].vs1; int kc = sc * 2;               \
    *(bf16x8*)((char*)K_lds + (b) * SHM_K + KSWZ(sr, kc)) = sr_[i].ks0;                       \
    *(bf16x8*)((char*)K_lds + (b) * SHM_K + KSWZ(32 + sr, kc)) = sr_[i].ks1; } while (0)
#define SWAIT() do { if constexpr (SD == 2) asm volatile("s_waitcnt vmcnt(4)" ::: "memory"); else asm volatile("s_waitcnt vmcnt(0)" ::: "memory"); } while (0)
#define RESC(a) do { if (__any((a) < 1.f)) { if (hi == 0) al_l[r32] = (a); asm volatile("s_waitcnt lgkmcnt(0)" ::: "memory"); \
    _Pragma("unroll") for (int d = 0; d < 4; ++d) _Pragma("unroll") for (int r = 0; r < 16; ++r) o[d][r] *= al_l[crow(r, hi)]; } } while (0)
  f32x16 pA0, pA1, pB0, pB1; float mnA, mnB, alA = 1.f, alB = 1.f; bf16x8 pa0, pa1, pa2, pa3; const int NT = seq / KVBLK;
  constexpr int SE = 0, SO = SD - 1;
  SLOAD(SE, 0); asm volatile("s_waitcnt vmcnt(0)" ::: "memory"); SWRITE(0, SE); __syncthreads();
  if (wid >= 4) __builtin_amdgcn_s_setprio(1);
  bool nA = NEED(0), nB = false;
  if (nA) { qkt(pA0, pA1, K_lds, qr, r32, hi); partialSM<WIN>(pA0, pA1, m_reg, mnA, alA, kqw, hi); }
  SLOAD(SO, KVBLK); if constexpr (SD == 2) { if (2 < NT) SLOAD(SE, 2 * KVBLK); }
  SWAIT(); SWRITE(1, SO); __syncthreads();
  for (int j = 1; j + 1 < NT; j += 2) {
    nB = NEED(j);
    SBAR(); if (nB) qkt(pB0, pB1, (bf16*)((char*)K_lds + SHM_K), qr, r32, hi);
    if (nA) finishSM(pA0, pA1, alA, l_reg, pa0, pa1, pa2, pa3); SBAR();
    SLOAD(SO, (j + SD) * KVBLK); SBAR();
    if (nA) pv_d0(o, vb0, pa0, pa1, pa2, pa3);
    alB = 1.f; if (nB) partialSM<WIN>(pB0, pB1, m_reg, mnB, alB, kqw + j * KVBLK, hi);
    __syncthreads(); SWAIT(); SWRITE(0, SE);
    RESC(alB); __syncthreads();
    nA = NEED(j + 1);
    SBAR(); if (nA) qkt(pA0, pA1, K_lds, qr, r32, hi);
    if (nB) finishSM(pB0, pB1, alB, l_reg, pa0, pa1, pa2, pa3); SBAR();
    if (SD == 1 || j + 3 < NT) SLOAD(SE, (j + 1 + SD) * KVBLK); SBAR();
    if (nB) pv_d0(o, vb0 + (int)SHM_V, pa0, pa1, pa2, pa3);
    alA = 1.f; if (nA) partialSM<WIN>(pA0, pA1, m_reg, mnA, alA, kqw + (j + 1) * KVBLK, hi);
    __syncthreads(); SWAIT(); SWRITE(1, SO);
    RESC(alA); __syncthreads();
  }
  nB = NEED(NT - 1);
  SBAR(); if (nB) qkt(pB0, pB1, (bf16*)((char*)K_lds + SHM_K), qr, r32, hi);
  if (nA) finishSM(pA0, pA1, alA, l_reg, pa0, pa1, pa2, pa3); SBAR();
  if (nA) pv_d0(o, vb0, pa0, pa1, pa2, pa3);
  alB = 1.f; if (nB) partialSM<WIN>(pB0, pB1, m_reg, mnB, alB, kqw + (NT - 1) * KVBLK, hi);
  __syncthreads(); RESC(alB);
  if (nB) { finishSM(pB0, pB1, alB, l_reg, pa0, pa1, pa2, pa3); SBAR();
    pv_d0(o, vb0 + (int)SHM_V, pa0, pa1, pa2, pa3); }
  __builtin_amdgcn_s_setprio(0);
  if (hi == 0) li_l[r32] = l_reg; asm volatile("s_waitcnt lgkmcnt(0)" ::: "memory");
  bf16* Ow = Ob + (long)wrow * LDO + wcol;
  const bool odd = (r32 & 1) != 0; float ssq_mine = 0.f;
#pragma unroll
  for (int r = 0; r < 16; ++r) { const int orow = crow(r, hi); const float rl = __builtin_amdgcn_rcpf(li_l[orow]);
    const float v0 = o[0][r] * rl, v1 = o[1][r] * rl, v2 = o[2][r] * rl, v3 = o[3][r] * rl;
    { float q = (v0 * v0 + v1 * v1) + (v2 * v2 + v3 * v3);
      q = dpp_add<0xB1, 0xf>(q); q = dpp_add<0x4E, 0xf>(q); q = dpp_add<0x141, 0xf>(q); q = dpp_add<0x140, 0xf>(q); q = dpp_add<0x142, 0xa>(q);
      if (r32 == 16 + r) ssq_mine = q; }
    const float sa = odd ? v0 : v2, sb = odd ? v1 : v3;
    const float ra = __shfl_xor(sa, 1), rb = __shfl_xor(sb, 1);
    const unsigned wa = odd ? cvtpk(ra, v2) : cvtpk(v0, ra), wb = odd ? cvtpk(rb, v3) : cvtpk(v1, rb);
    unsigned* dst = (unsigned*)(Ow + (long)orow * LDO + (odd ? 64 : 0) + (r32 & ~1));
    dst[0] = wa; dst[16] = wb; }
  if (r32 >= 16) Sp[(long)(wrow + crow(r32 - 16, hi)) * 16 + (WIN ? (wid >> 2) : 0)] = ssq_mine;
  __syncthreads();
#undef SLOAD
#undef SWRITE
#undef SWAIT
#undef RESC
#undef NEED
}
#undef KSWZ
#undef SBAR
}


__device__ __forceinline__ void tr_item(const float* W, int ldw, int k0, int n0, const float* ks, bf16* WT, int ldk, int drow0, LAS float* scr, int lane) {
    f32x4 v[8];
    const int lr = lane >> 3, lc = (lane & 7) * 4;
#pragma unroll
    for (int q = 0; q < 8; ++q) v[q] = __builtin_nontemporal_load((const f32x4*)(W + (size_t)(k0 + q * 8 + lr) * ldw + n0 + lc));
#pragma unroll
    for (int q = 0; q < 8; ++q) { const int kk = q * 8 + lr; const float s = ks ? ks[kk] : 1.f; LAS float* d = scr + kk * 33 + lc; d[0] = v[q].x * s; d[1] = v[q].y * s; d[2] = v[q].z * s; d[3] = v[q].w * s; }
    asm volatile("s_waitcnt lgkmcnt(0)" ::: "memory");
    const int c = lane & 7;
#pragma unroll
    for (int j = 0; j < 4; ++j) { const int n = lr + 8 * j; const LAS float* s = scr + (8 * c) * 33 + n;
        v4u o; o.x = pk2(s[0 * 33], s[1 * 33]); o.y = pk2(s[2 * 33], s[3 * 33]); o.z = pk2(s[4 * 33], s[5 * 33]); o.w = pk2(s[6 * 33], s[7 * 33]);
        *(v4u*)(WT + (size_t)(drow0 + n) * ldk + k0 + 8 * c) = o; }
    asm volatile("s_waitcnt lgkmcnt(0)" ::: "memory");
}
struct Tr8 { f32x4 v[2][8]; };
__device__ __forceinline__ void tr8_load(Tr8& t, const float* W, int ldw, int k0, int n0, int lane) {
    const int lr = lane >> 3, lc = (lane & 7) * 4;
#pragma unroll
    for (int hf = 0; hf < 2; ++hf)
#pragma unroll
        for (int q = 0; q < 8; ++q) t.v[hf][q] = __builtin_nontemporal_load((const f32x4*)(W + (size_t)(k0 + hf * 64 + q * 8 + lr) * ldw + n0 + lc));
}
__device__ __forceinline__ void tr8_finish(const Tr8& t, int k0, float sc, unsigned char* WT, int ldk, int drow0, LAS float* scr, int lane) {
    LAS unsigned* s32 = (LAS unsigned*)scr;
    { const int lr = lane >> 3, lcg = lane & 7;
#pragma unroll
      for (int hf = 0; hf < 2; ++hf)
#pragma unroll
        for (int q = 0; q < 8; ++q) { const int k = hf * 64 + q * 8 + lr; const f32x4 v = t.v[hf][q] * sc;
            unsigned w = 0; w = __builtin_amdgcn_cvt_pk_fp8_f32(v.x, v.y, w, false); w = __builtin_amdgcn_cvt_pk_fp8_f32(v.z, v.w, w, true);
            s32[(k + (k >> 4)) * 8 + lcg] = w; } }
    asm volatile("s_waitcnt lgkmcnt(0)" ::: "memory");
    const int n4 = lane & 7, c = lane >> 3;
    unsigned d[16];
#pragma unroll
    for (int i = 0; i < 16; ++i) d[i] = s32[(16 * c + i + c) * 8 + n4];
    v4u o[4];
#pragma unroll
    for (int q = 0; q < 4; ++q) {
        const unsigned t0 = __builtin_amdgcn_perm(d[4 * q + 1], d[4 * q + 0], 0x05010400u), t1 = __builtin_amdgcn_perm(d[4 * q + 1], d[4 * q + 0], 0x07030602u);
        const unsigned t2 = __builtin_amdgcn_perm(d[4 * q + 3], d[4 * q + 2], 0x05010400u), t3 = __builtin_amdgcn_perm(d[4 * q + 3], d[4 * q + 2], 0x07030602u);
        o[0][q] = __builtin_amdgcn_perm(t2, t0, 0x05040100u); o[1][q] = __builtin_amdgcn_perm(t2, t0, 0x07060302u);
        o[2][q] = __builtin_amdgcn_perm(t3, t1, 0x05040100u); o[3][q] = __builtin_amdgcn_perm(t3, t1, 0x07060302u); }
#pragma unroll
    for (int r = 0; r < 4; ++r) __builtin_nontemporal_store(o[r], (v4u*)(WT + (size_t)(drow0 + n4 * 4 + r) * ldk + k0 + 16 * c));
    asm volatile("s_waitcnt lgkmcnt(0)" ::: "memory");
}
__device__ __forceinline__ void tr_item8(const float* W, int ldw, int k0, int n0, float sc, unsigned char* WT, int ldk, int drow0, LAS float* scr, int lane) {
    Tr8 t; tr8_load(t, W, ldw, k0, n0, lane); asm volatile("" ::: "memory"); tr8_finish(t, k0, sc, WT, ldk, drow0, scr, lane);
}
#ifndef DENSE_DN_FP8
#define DENSE_DN_FP8 1
#endif
#ifndef EXP_IN_ATTN
#define EXP_IN_ATTN 1
#endif
struct ExpIt { const float* W; unsigned char* WT; int ldw, ldk, k0, n0, drow0; };
__device__ __forceinline__ ExpIt exp_desc(const Args& a, int r) {
    ExpIt d; const int m = r / 2816; r %= 2816;
    if (m >= 16) { const int e = m - 16, kb = r / 64, nn = r % 64; d.W = a.in[21] + (size_t)e * FF * DM; d.ldw = DM; d.k0 = kb * 128; d.n0 = nn * 32; d.WT = a.ws + WS_EDN + (size_t)e * EDN_STRIDE; d.ldk = FF; d.drow0 = nn * 32; }
    else { const bool up = m >= 8; const int e = m & 7, kb = r / 176, nn = r % 176, n0 = nn * 32; d.W = (up ? a.in[20] : a.in[19]) + (size_t)e * DM * FF; d.ldw = FF; d.k0 = kb * 128; d.n0 = n0;
        d.WT = a.ws + WS_EGU + (size_t)e * EGU_STRIDE; d.ldk = DM; d.drow0 = (n0 >> 7) * 256 + (n0 & 127) + (up ? 128 : 0); }
    return d;
}
__device__ __forceinline__ void exp_item(const Args& a, int r, LAS float* scr, int lane) { const ExpIt d = exp_desc(a, r); tr_item8(d.W, d.ldw, d.k0, d.n0, W8_SCALE, d.WT, d.ldk, d.drow0, scr, lane); }
#ifndef INPROJ1_FP8
#define INPROJ1_FP8 1
#endif
#ifndef DENSE_GU_FP8
#define DENSE_GU_FP8 1
#endif
constexpr int TR_IN0 = 32 * 96, TR_IN = TR_IN0 + (INPROJ1_FP8 ? 16 * 96 : 32 * 96), TR_OUT = 2 * 32 * 64, TR_F = 5632, TR_F8 = 2816, TR_GU = DENSE_GU_FP8 ? TR_F8 : TR_F, TR_DENSE = 2 * TR_GU + (DENSE_DN_FP8 ? TR_F8 : TR_F), TR_ITEMS = TR_IN + TR_OUT + TR_DENSE + (EXP_IN_ATTN ? 0 : 24 * TR_F8);
__device__ __forceinline__ void ph_weights(const Args& a, LAS unsigned char* lds, int bid, int nb, int tid) {
    const int wave = tid >> 6, lane = tid & 63;
    LAS float* scr = (LAS float*)(lds + wave * 16896);
    for (int it = bid * NWAVES + wave; it < TR_ITEMS; it += nb * NWAVES) {
        int r = it;
        if (r < TR_IN) { const int l = r < TR_IN0 ? 0 : 1; if (l) r -= TR_IN0; const int kb = r / 96, nn = r % 96;
            if (INPROJ1_FP8 && l == 1) tr_item8(a.in[8] + (size_t)DM * NQKV, NQKV, kb * 128, nn * 32, W8_SCALE, a.ws + WS_WIN + WIN_STRIDE, DM, nn * 32, scr, lane);
            else tr_item(a.in[8] + (size_t)l * DM * NQKV, NQKV, kb * 64, nn * 32, nullptr, (bf16*)(a.ws + WS_WIN + l * WIN_STRIDE), DM, nn * 32, scr, lane);
            continue; }
        r -= TR_IN;
        if (r < TR_OUT) { const int l = r / 2048; r %= 2048; const int kb = r / 64, nn = r % 64, k0 = kb * 64;
            const float* ks = k0 < 1024 ? a.in[12] + l * 1024 + k0 : a.in[13] + l * 1024 + (k0 - 1024);
            tr_item(a.in[14] + (size_t)l * DM * DM, DM, k0, nn * 32, ks, (bf16*)(a.ws + WS_WOUT + l * WOUT_STRIDE), DM, nn * 32, scr, lane); continue; }
        r -= TR_OUT;
        if (r < TR_DENSE) {
            const int m = r < 2 * TR_GU ? r / TR_GU : 2; r -= m * TR_GU;
            if (m == 2) { if (DENSE_DN_FP8) { const int kb = r / 64, nn = r % 64; tr_item8(a.in[17], DM, kb * 128, nn * 32, W8_SCALE, a.ws + WS_WDN, FF, nn * 32, scr, lane); }
                          else { const int kb = r / 64, nn = r % 64; tr_item(a.in[17], DM, kb * 64, nn * 32, nullptr, (bf16*)(a.ws + WS_WDN), FF, nn * 32, scr, lane); } }
            else { const int kb = r / 176, nn = r % 176, n0 = nn * 32;
                if (DENSE_GU_FP8) tr_item8(m == 0 ? a.in[15] : a.in[16], FF, kb * 128, n0, W8_SCALE, a.ws + WS_WGU, DM, (n0 >> 7) * 256 + (n0 & 127) + (m == 1 ? 128 : 0), scr, lane);
                else tr_item(m == 0 ? a.in[15] : a.in[16], FF, kb * 64, n0, nullptr, (bf16*)(a.ws + WS_WGU), DM, (n0 >> 7) * 256 + (n0 & 127) + (m == 1 ? 128 : 0), scr, lane); }
            continue; }
        r -= TR_DENSE;
        if (!EXP_IN_ATTN) exp_item(a, r, scr, lane);
    }
}
__device__ __forceinline__ void ph_expert_burst(const Args& a, LAS unsigned char* lds, int bid, int nb) {
    const int tid = fresh_tid(), wave = __builtin_amdgcn_readfirstlane(tid >> 6), lane = tid & 63;
    LAS float* scr = (LAS float*)(lds + wave * 16896);
    const int st = nb * NWAVES, NIT = 24 * TR_F8;
    for (int it = bid * NWAVES + wave; it < NIT; it += 3 * st) {
        const int i1 = it + st < NIT ? it + st : it, i2 = it + 2 * st < NIT ? it + 2 * st : it;
        const ExpIt d0 = exp_desc(a, it), d1 = exp_desc(a, i1), d2 = exp_desc(a, i2);
        Tr8 A, B, C;
        tr8_load(A, d0.W, d0.ldw, d0.k0, d0.n0, lane); tr8_load(B, d1.W, d1.ldw, d1.k0, d1.n0, lane); tr8_load(C, d2.W, d2.ldw, d2.k0, d2.n0, lane);
        asm volatile("" ::: "memory");
        tr8_finish(A, d0.k0, W8_SCALE, d0.WT, d0.ldk, d0.drow0, scr, lane);
        if (it + st < NIT) tr8_finish(B, d1.k0, W8_SCALE, d1.WT, d1.ldk, d1.drow0, scr, lane);
        if (it + 2 * st < NIT) tr8_finish(C, d2.k0, W8_SCALE, d2.WT, d2.ldk, d2.drow0, scr, lane);
    }
    asm volatile("s_waitcnt vmcnt(0)" ::: "memory");
    __syncthreads();
}

__device__ __forceinline__ void ph_attn(const Args& a, int l, char* lds, int bid, int nb) {
    const bf16* qkv = (const bf16*)(a.ws + WS_QKV); bf16* attb = (bf16*)(a.ws + WS_ATT);
    const float* ropeT = (const float*)(a.ws + WS_ROPE);
    float* ssq = (float*)(a.ws + WS_SSQ);
    const int n_before = (EXP_IN_ATTN && l == 0) ? ((bid >> 3) & 3) : 0;
    int U = bid;
    for (int i = 0; i < n_before && U < 1024; ++i, U += nb) {
        const int x = U & 7, j = (U >> 3) & 31, g = (U >> 8) * 8 + x, b = g >> 1, kvh = g & 1, hq = kvh * 4 + (j >> 3), q0 = (j & 7) * 256;
        const size_t tok0 = (size_t)b * SEQ;
        att::attn_unit<false>(qkv + (tok0 + q0) * NQKV + QA_OFF + hq * HD, qkv + tok0 * NQKV + KA_OFF + kvh * HD, qkv + tok0 * NQKV + VA_OFF + kvh * HD,
                              attb + (tok0 + q0) * DM + hq * HD, SEQ, 0, nullptr, a.in[9] + l * HD, ropeT, ropeT + 2048 * 64, q0, ssq + (tok0 + q0) * 16 + hq, lds);
    }
    if (EXP_IN_ATTN && l == 0) ph_expert_burst(a, (LAS unsigned char*)lds, bid, nb);
    for (; U < 1024; U += nb) {
        const int x = U & 7, j = (U >> 3) & 31, g = (U >> 8) * 8 + x, b = g >> 1, kvh = g & 1, hq = kvh * 4 + (j >> 3), q0 = (j & 7) * 256;
        const size_t tok0 = (size_t)b * SEQ;
        att::attn_unit<false>(qkv + (tok0 + q0) * NQKV + QA_OFF + hq * HD, qkv + tok0 * NQKV + KA_OFF + kvh * HD, qkv + tok0 * NQKV + VA_OFF + kvh * HD,
                              attb + (tok0 + q0) * DM + hq * HD, SEQ, 0, nullptr, a.in[9] + l * HD, ropeT, ropeT + 2048 * 64, q0, ssq + (tok0 + q0) * 16 + hq, lds);
    }
    for (int U = bid; U < 1024; U += nb) {
        const int x = U & 7, j = (U >> 3) & 31, g = (U >> 8) * 8 + x, b = g >> 1, kvh = g & 1, q0 = (j >> 1) * 128, h0 = kvh * 4 + (j & 1) * 2;
        const size_t tok0 = (size_t)b * SEQ;
        const int klo = q0 - 128 < 0 ? 0 : q0 - 128, khi = q0 + 256 > SEQ ? SEQ : q0 + 256;
        att::attn_unit<true>(qkv + (tok0 + q0) * NQKV + QB_OFF + h0 * HD, qkv + (tok0 + klo) * NQKV + KB_OFF + kvh * HD, qkv + (tok0 + klo) * NQKV + VB_OFF + kvh * HD,
                             attb + (tok0 + q0) * DM + 1024 + h0 * HD, khi - klo, klo - q0, a.in[11] + l * 8 + h0, nullptr, ropeT + 2 * 2048 * 64, ropeT + 3 * 2048 * 64, q0, ssq + (tok0 + q0) * 16 + 8 + h0, lds);
    }
}


#define XB_TMO      128
#define XB_XCNT(j)  (256  + 64 * (j))
#define XB_XSUB(j)  (1280 + 64 * (j))
#define XB_XGEN(j)  (2304 + 64 * (j))
#define XB_TOP      3328
#define XB_TOPGEN   3392
#define XCD_BAR_WORDS 3456
#define XB_SPIN_CAP (1u << 18)
__device__ __forceinline__ unsigned xb_ld(unsigned* p)              { return __hip_atomic_load(p, __ATOMIC_RELAXED, __HIP_MEMORY_SCOPE_AGENT); }
__device__ __forceinline__ unsigned xb_add(unsigned* p, unsigned v) { return __hip_atomic_fetch_add(p, v, __ATOMIC_RELAXED, __HIP_MEMORY_SCOPE_AGENT); }
__device__ __forceinline__ unsigned xb_xcc_id() { return (unsigned)__builtin_amdgcn_s_getreg((3 << 11) | 20) & 0xFu; }
#define XB_SPIN(cond, bar) do { unsigned _sp = 0; while (cond) { __builtin_amdgcn_s_sleep(1); \
    if ((++_sp & 255u) == 0u) { if (xb_ld(&(bar)[XB_TMO])) break; if (_sp > XB_SPIN_CAP) { atomicAdd(&(bar)[XB_TMO], 1u); break; } } } } while (0)
struct XcdBarrier { unsigned* bar; unsigned x; volatile LAS unsigned* st; };
__device__ __forceinline__ XcdBarrier xcd_barrier_post(unsigned* bar, volatile LAS unsigned* st) {
    XcdBarrier b; b.bar = bar; b.x = xb_xcc_id(); b.st = st;
    if (threadIdx.x == 0) (void)xb_add(&bar[XB_XCNT(b.x)], 1u);
    return b;
}
__device__ __forceinline__ void xcd_barrier_complete(unsigned* bar, unsigned x, unsigned& nloc, unsigned& nx) {
    const unsigned G = gridDim.x * gridDim.y * gridDim.z;
    unsigned sum, cnt, mine, sp = 0u;
    for (;;) {
        sum = 0u; cnt = 0u; mine = 0u;
#pragma unroll
        for (unsigned j = 0; j < 16; ++j) { const unsigned c = xb_ld(&bar[XB_XCNT(j)]); sum += c; cnt += (c > 0u) ? 1u : 0u; mine = (j == x) ? c : mine; }
        if (sum == G) break;
        __builtin_amdgcn_s_sleep(1);
        if ((++sp & 255u) == 0u) { if (xb_ld(&bar[XB_TMO])) break; if (sp > XB_SPIN_CAP) { atomicAdd(&bar[XB_TMO], 1u); break; } }
    }
    nloc = mine > 0u ? mine : 1u; nx = cnt > 0u ? cnt : 1u;
}
__device__ __forceinline__ void xcd_barrier(const XcdBarrier& b) {
    asm volatile("s_waitcnt vmcnt(0)" ::: "memory");
    __syncthreads();
    if (threadIdx.x == 0) {
        unsigned* bar = b.bar;
        __builtin_amdgcn_s_waitcnt(0);
        unsigned nloc = b.st[0], nx = b.st[1];
        if (nloc == 0u) { xcd_barrier_complete(bar, b.x, nloc, nx); b.st[0] = nloc; b.st[1] = nx; }
        const unsigned old = xb_add(&bar[XB_XSUB(b.x)], 1u);
        const unsigned gen = old / nloc;
        if (old + 1u == (gen + 1u) * nloc) {
            __builtin_amdgcn_fence(__ATOMIC_RELEASE, "agent");
            asm volatile("s_waitcnt vmcnt(0)" ::: "memory");
            const unsigned og = xb_add(&bar[XB_TOP], 1u);
            const unsigned tg = og / nx;
            if (og + 1u == (tg + 1u) * nx) xb_add(&bar[XB_TOPGEN], 1u);
            else XB_SPIN(xb_ld(&bar[XB_TOPGEN]) == tg, bar);
            __builtin_amdgcn_fence(__ATOMIC_ACQUIRE, "agent");
            xb_add(&bar[XB_XGEN(b.x)], 1u);
            asm volatile("s_waitcnt vmcnt(0)" ::: "memory");
        } else {
            XB_SPIN(xb_ld(&bar[XB_XGEN(b.x)]) == gen, bar);
            __builtin_amdgcn_fence(__ATOMIC_ACQUIRE, "agent");
            asm volatile("s_waitcnt vmcnt(0)" ::: "memory");
        }
    }
    __syncthreads();
}
constexpr int CW_BAR = 4096;
constexpr int LDS_XB = LDS_BYTES - 16;

#ifndef WGM_IN
#define WGM_IN 4
#endif
#ifndef WGM_OUT
#define WGM_OUT 4
#endif
#ifndef WGM_GU
#define WGM_GU 4
#endif
#ifndef WGM_DN
#define WGM_DN 4
#endif
#ifndef WGM_EGU
#define WGM_EGU 4
#endif
#ifndef WGM_EDN
#define WGM_EDN 4
#endif
__global__ void __launch_bounds__(NTHR, 2) mega(Args a) {
    extern __shared__ __attribute__((aligned(16))) unsigned char lds_raw[];
    LAS unsigned char* lds = (LAS unsigned char*)lds_raw;
    const int bid = blockIdx.x, nb = gridDim.x;
    const int lo = a.ph_lo, hi = a.ph_hi;
#define PH_TID const int tid = fresh_tid(), wave = __builtin_amdgcn_readfirstlane(tid >> 6), lane = tid & 63; (void)wave; (void)lane
#define IN(k) (lo <= (k) && (k) < hi)
#define REPS(id) ((PROBE_DUP == (id)) ? 2 : 1)
#define SEAM(k) do { if (IN(k) && IN((k) + 1)) xcd_barrier(bar); } while (0)
    if (threadIdx.x < 4) ((LAS unsigned*)(lds + LDS_XB))[threadIdx.x] = 0u;
    __syncthreads();
    XcdBarrier bar; bar.bar = (unsigned*)(a.ws + WS_CTL) + CW_BAR; bar.x = 0; bar.st = nullptr;
    if (hi - lo > 1) bar = xcd_barrier_post((unsigned*)(a.ws + WS_CTL) + CW_BAR, (volatile LAS unsigned*)(lds + LDS_XB));
    const float* modv = (const float*)(a.ws + WS_MODV);
    bf16* hbuf = (bf16*)(a.ws + WS_H);
    if (IN(0)) for (int rep = 0; rep < REPS(1); ++rep) { PH_TID; ph_mod(a, lds, bid, nb, tid); ph_tables(a, bid, nb, tid); ph_weights(a, lds, bid, nb, tid); __syncthreads(); }
    SEAM(0);
    if (IN(1)) for (int rep = 0; rep < REPS(6); ++rep) { PH_TID;
        constexpr int HIN = 1;
#define LD0(R, t) do { const float* mv = modv + (size_t)(0 * 16 + ((t) >> 11)) * NMOD; row_load<0, HIN, false>(R, t, lane, a.in[0], nullptr, nullptr, nullptr, nullptr, mv + 1 * DM, mv + 0 * DM); } while (0)
#define FN0(R, t) row_finish<0, HIN, false, false>(R, t, lane, nullptr, hbuf, nullptr, nullptr, nullptr)
        ROW_LOOP(0, HIN, LD0, FN0);
#undef LD0
#undef FN0
    }
    SEAM(1);
    if (PROBE_DUP == 8) for (int rep = 0; rep < 20; ++rep) xcd_barrier(bar);
    if (IN(2)) for (int rep = 0; rep < REPS(2); ++rep) { pg8::StaticOrder S; S.init(T / 256, NQKV / 256, nb, bid, WGM_IN); pg8::EpiPlain E{(bf16*)(a.ws + WS_QKV), NQKV, 1.0f};
        pg8::gemm_phase<pg8::EpiPlain, false, false>(lds, (const char*)hbuf, nullptr, (const char*)(a.ws + WS_WIN), nullptr, 0, DM, S, E); }
    SEAM(2);
    for (int l = 0; l < DEPTH; ++l) {
        const int base = 2 + 11 * l; const bool moe = (l & 1) != 0;
        if (IN(base + 1)) { PH_TID; ph_prep(a, l, bid, nb, tid); }
        SEAM(base + 1);
        if (IN(base + 2)) for (int rep = 0; rep < REPS(3); ++rep) ph_attn(a, l, (char*)lds_raw, bid, nb);
        SEAM(base + 2);
        if (IN(base + 3)) for (int rep = 0; rep < REPS(11); ++rep) { PH_TID; ph_attn_norm(a, bid, nb, tid); }
        SEAM(base + 3);
        if (IN(base + 4)) for (int rep = 0; rep < REPS(9); ++rep) { pg8::StaticOrder S; S.init(T / 256, DM / 256, nb, bid, WGM_OUT); pg8::EpiRowScale E{(bf16*)(a.ws + WS_Y), DM, (const float*)(a.ws + WS_FAC)};
            pg8::gemm_phase<pg8::EpiRowScale, false, false>(lds, (const char*)(a.ws + WS_ATT), nullptr, (const char*)(a.ws + WS_WOUT + l * WOUT_STRIDE), nullptr, 0, DM, S, E); }
        SEAM(base + 4);
        if (IN(base + 5)) for (int rep = 0; rep < (l == 0 ? REPS(7) : 1); ++rep) { PH_TID;
            const bf16* y = (const bf16*)(a.ws + WS_Y); float* xb = (float*)(a.ws + WS_XB);
            if (moe) {
                LAS float* wrT = (LAS float*)lds;
                const float* wr = a.in[18] + (size_t)(l >> 1) * DM * NE;
                for (int i = tid; i < DM * NE; i += NTHR) { const int d = i >> 3, e = i & 7; wrT[e * DM + d] = wr[i]; }
                __syncthreads();
#define LD5M(R, t) do { const float* mv = modv + (size_t)(l * 16 + ((t) >> 11)) * NMOD; row_load<1, 2, true>(R, t, lane, xb, y, nullptr, nullptr, mv + 2 * DM, mv + 4 * DM, mv + 3 * DM); } while (0)
#define FN5M(R, t) row_finish<1, 2, true, true>(R, t, lane, xb, (bf16*)(a.ws + WS_H8), wrT, (int*)(a.ws + WS_TOPI), (float*)(a.ws + WS_TOPW))
                ROW_LOOP(1, 2, LD5M, FN5M);
                __syncthreads();
            } else {
#define LD5D(R, t) do { const float* mv = modv + (size_t)(l * 16 + ((t) >> 11)) * NMOD; row_load<1, DENSE_GU_FP8 ? 2 : 1, false>(R, t, lane, a.in[0], y, nullptr, nullptr, mv + 2 * DM, mv + 4 * DM, mv + 3 * DM); } while (0)
#define FN5D(R, t) row_finish<1, DENSE_GU_FP8 ? 2 : 1, false, true>(R, t, lane, xb, DENSE_GU_FP8 ? (bf16*)(a.ws + WS_H8) : hbuf, nullptr, nullptr, nullptr)
                ROW_LOOP(1, DENSE_GU_FP8 ? 2 : 1, LD5D, FN5D);
            }
#undef LD5M
#undef FN5M
#undef LD5D
#undef FN5D
        }
        SEAM(base + 5);
        if (IN(base + 6) && moe) for (int rep = 0; rep < REPS(14); ++rep) { PH_TID; ph_route_cnt(a, lds, bid, nb, tid); }
        if (moe) SEAM(base + 6);
        if (IN(base + 7) && moe) for (int rep = 0; rep < REPS(14); ++rep) { PH_TID; ph_route_build(a, lds, bid, nb, tid); }
        if (moe) SEAM(base + 7);
        if (IN(base + 8)) for (int rep = 0; rep < (moe ? REPS(5) : REPS(4)); ++rep) {
            if (!moe) { pg8::StaticOrder S; S.init(T / 256, 2 * FF / 256, nb, bid, WGM_GU);
#if DENSE_DN_FP8
                pg8::EpiSwiglu8 E{(unsigned char*)(a.ws + WS_ACT), FF, DENSE_GU_FP8 ? W8_INV : 1.0f};
                pg8::gemm_phase<pg8::EpiSwiglu8, false, false, DENSE_GU_FP8 != 0>(lds, (const char*)(DENSE_GU_FP8 ? (bf16*)(a.ws + WS_H8) : hbuf), nullptr, (const char*)(a.ws + WS_WGU), nullptr, 0, DM, S, E); }
#else
                pg8::EpiSwiglu E{(bf16*)(a.ws + WS_ACT), FF};
                pg8::gemm_phase<pg8::EpiSwiglu, false, false>(lds, (const char*)hbuf, nullptr, (const char*)(a.ws + WS_WGU), nullptr, 0, DM, S, E); }
#endif
            else { const int* tile = (const int*)(a.ws + WS_TILE); const int ntile = __builtin_amdgcn_readfirstlane(tile[512]);
                pg8::StaticOrder S; S.init(ntile, 2 * FF / 256, nb, bid, WGM_EGU); pg8::EpiSwiglu8 E{(unsigned char*)(a.ws + WS_ACTM), FF, W8_INV};
                pg8::gemm_phase<pg8::EpiSwiglu8, true, true, true>(lds, (const char*)(a.ws + WS_H8), (const int*)(a.ws + WS_ROWL), (const char*)(a.ws + WS_EGU), tile, EGU_STRIDE, DM, S, E); }
        }
        SEAM(base + 8);
        if (IN(base + 9)) for (int rep = 0; rep < (moe ? REPS(5) : REPS(4)); ++rep) {
            if (!moe) { pg8::StaticOrder S; S.init(T / 256, DM / 256, nb, bid, WGM_DN); pg8::EpiPlain E{(bf16*)(a.ws + WS_Y2), DM, DENSE_DN_FP8 ? W8_INV : 1.0f};
                pg8::gemm_phase<pg8::EpiPlain, false, false, DENSE_DN_FP8 != 0>(lds, (const char*)(a.ws + WS_ACT), nullptr, (const char*)(a.ws + WS_WDN), nullptr, 0, FF, S, E); }
            else { const int* tile = (const int*)(a.ws + WS_TILE); const int ntile = __builtin_amdgcn_readfirstlane(tile[512]);
                const int nmain = (ntile * (DM / 256) / nb) * nb / (DM / 256);
                pg8::StaticOrder S; S.init(nmain, DM / 256, nb, bid, WGM_EDN); pg8::EpiPlain E{(bf16*)(a.ws + WS_YS), DM, W8_INV};
                pg8::gemm_phase<pg8::EpiPlain, false, true, true>(lds, (const char*)(a.ws + WS_ACTM), nullptr, (const char*)(a.ws + WS_EDN), tile, EDN_STRIDE, FF, S, E); }
        }
        SEAM(base + 9);
        if (IN(base + 10)) { PH_TID;
            static_assert(DEPTH == 2, "row_end variants: layer 0 = dense FFN + next layer's h, layer 1 = MoE combine, last");
            constexpr int HN = INPROJ1_FP8 ? 2 : 1;
            float* xb = (float*)(a.ws + WS_XB);
#define LD10D(R, t) do { const float* mv = modv + (size_t)(l * 16 + ((t) >> 11)) * NMOD; const float* mn = modv + (size_t)((l + 1) * 16 + ((t) >> 11)) * NMOD; \
                row_load<1, HN, true>(R, t, lane, xb, (const bf16*)(a.ws + WS_Y2), nullptr, nullptr, mv + 5 * DM, mn + 1 * DM, mn + 0 * DM); } while (0)
#define FN10D(R, t) row_finish<1, HN, false, true>(R, t, lane, xb, INPROJ1_FP8 ? (bf16*)(a.ws + WS_H8) : hbuf, nullptr, nullptr, nullptr)
#define LD10M(R, t) do { const float* mv = modv + (size_t)(l * 16 + ((t) >> 11)) * NMOD; \
                row_load<2, 0, true>(R, t, lane, xb, (const bf16*)(a.ws + WS_YS), (const int*)(a.ws + WS_SLOT), (const float*)(a.ws + WS_TOPW), mv + 5 * DM, nullptr, nullptr); } while (0)
#define FN10M(R, t) row_finish<2, 0, false, false>(R, t, lane, a.out, nullptr, nullptr, nullptr, nullptr)
            if (moe) { const int* slot_of = (const int*)(a.ws + WS_SLOT); const float* topw = (const float*)(a.ws + WS_TOPW);
                const int* tile = (const int*)(a.ws + WS_TILE); const int ntile = __builtin_amdgcn_readfirstlane(tile[512]);
                const int nmain = (ntile * (DM / 256) / nb) * nb / (DM / 256), ntail = ntile - nmain, R = ntail * (DM / 256);
                const float* gv = modv + (size_t)(l * 16) * NMOD + 5 * DM;
                if (bid < R) { pg8::StaticOrder S; S.init(ntail, DM / 256, R, bid, WGM_EDN); pg8::EpiPlain E{(bf16*)(a.ws + WS_YS) + (size_t)nmain * 256 * DM, DM, W8_INV};
                    pg8::gemm_phase<pg8::EpiPlain, false, true, true>(lds, (const char*)(a.ws + WS_ACTM) + (size_t)nmain * 256 * FF, nullptr, (const char*)(a.ws + WS_EDN), tile + nmain, EDN_STRIDE, FF, S, E); }
                else { const int st = (nb - R) * NWAVES; int t = (bid - R) * NWAVES + wave; Slots cur{0, 0, 0.f, 0.f};
                    if (t < T) { cur.s0 = slot_of[2 * t]; cur.s1 = slot_of[2 * t + 1]; cur.w0 = topw[2 * t]; cur.w1 = topw[2 * t + 1]; }
                    for (; t < T; t += st) { RowIn<2, 0> R_; Slots nxt; const int tn = t + st < T ? t + st : t;
                        row_load_moe(R_, t, tn, lane, (const bf16*)xb, (const bf16*)(a.ws + WS_YS), slot_of, topw, cur, nxt, gv + (size_t)(t >> 11) * NMOD);
                        FN10M(R_, t); cur = nxt; } }
                if (R > 0) { xcd_barrier(bar);
                    const int* rowl = (const int*)(a.ws + WS_ROWL);
                    for (int sl = nmain * 256 + bid * NWAVES + wave; sl < ntile * 256; sl += nb * NWAVES) { const int t = rowl[sl]; RowIn<2, 0> R_; Slots cur, nxt;
                        cur.s0 = slot_of[2 * t]; cur.s1 = slot_of[2 * t + 1]; cur.w0 = topw[2 * t]; cur.w1 = topw[2 * t + 1];
                        row_load_moe(R_, t, t, lane, (const bf16*)xb, (const bf16*)(a.ws + WS_YS), slot_of, topw, cur, nxt, gv + (size_t)(t >> 11) * NMOD);
                        FN10M(R_, t); } } }
            else ROW_LOOP(1, HN, LD10D, FN10D);
#undef LD10D
#undef FN10D
#undef LD10M
#undef FN10M
        }
        SEAM(base + 10);
        if (l + 1 < DEPTH) {
            if (IN(base + 11)) for (int rep = 0; rep < REPS(2); ++rep) { pg8::StaticOrder S; S.init(T / 256, NQKV / 256, nb, bid, WGM_IN);
#if INPROJ1_FP8
                pg8::EpiPlain E{(bf16*)(a.ws + WS_QKV), NQKV, W8_INV};
                pg8::gemm_phase<pg8::EpiPlain, false, false, true>(lds, (const char*)(a.ws + WS_H8), nullptr, (const char*)(a.ws + WS_WIN + (l + 1) * WIN_STRIDE), nullptr, 0, DM, S, E); }
#else
                pg8::EpiPlain E{(bf16*)(a.ws + WS_QKV), NQKV, 1.0f};
                pg8::gemm_phase<pg8::EpiPlain, false, false>(lds, (const char*)hbuf, nullptr, (const char*)(a.ws + WS_WIN + (l + 1) * WIN_STRIDE), nullptr, 0, DM, S, E); }
#endif
            SEAM(base + 11);
        }
    }
#undef IN
#undef SEAM
#undef PH_TID
}

extern "C" void kernel_launch(void* const* d_in, const int* in_sizes, int n_in, void* d_out, int out_size, void* d_ws, size_t ws_size, hipStream_t stream) {
    static int grid = 0;
    if (grid == 0) {
        if (n_in != 22 || in_sizes[0] != T * DM || out_size != T * DM || ws_size < WS_END) {
            fprintf(stderr, "kernel_launch: unexpected shapes: n_in %d in0 %d out %d ws %zu (need %zu); nothing launched\n", n_in, n_in > 0 ? in_sizes[0] : -1, out_size, ws_size, (size_t)WS_END);
            grid = -1; return; }
        int dev = 0, cus = 0;
        if (hipGetDevice(&dev) != hipSuccess || hipDeviceGetAttribute(&cus, hipDeviceAttributeMultiprocessorCount, dev) != hipSuccess) { grid = -1; return; }
        if (hipFuncSetAttribute((const void*)mega, hipFuncAttributeMaxDynamicSharedMemorySize, LDS_BYTES) != hipSuccess) { fprintf(stderr, "kernel_launch: hipFuncSetAttribute failed\n"); grid = -1; return; }
        int per_cu = 0;
        if (hipOccupancyMaxActiveBlocksPerMultiprocessor(&per_cu, (const void*)mega, NTHR, LDS_BYTES) != hipSuccess || per_cu < 1)
            fprintf(stderr, "kernel_launch: note: the occupancy query reports %d workgroups per CU\n", per_cu);
        (void)hipGetLastError();
        grid = cus;
    }
    if (grid < 0) return;
    (void)hipMemsetAsync((char*)d_ws + WS_CTL, 0, CTL_ZERO_BYTES, stream);
    Args a{};
    for (int i = 0; i < 22; ++i) a.in[i] = (const float*)d_in[i];
    a.out = (float*)d_out; a.ws = (unsigned char*)d_ws;
    a.ph_lo = 0; a.ph_hi = 2 + 11 * DEPTH;
    hipLaunchKernelGGL(mega, dim3(grid), dim3(NTHR), LDS_BYTES, stream, a);
}
```
